# Optimizing an MI355X kernel written in HIP

```python
import jax
import jax.numpy as jnp
from jax import lax
import numpy as np

D_MODEL = 1024
BATCH = 32
SEQ = 256
DEPTH = 4
DEC_BATCH = 4
DEC_SEQ = 4096
PAST_LEN = 512

GRID_W = 64
N_EVEN = (DEPTH + 1) // 2
N_ODD = DEPTH // 2
EPS = 1e-6
NEG_INF = -1e30
ROPE_BASE = 10000.0
ATTN_Q_BLOCK = 128

A_HEADS = 4
A_DK = 64
A_DV = 128
A_GATE_RANK = 16
A_GATE_TAU = 16.0
A_CHUNK = 64

B_HEADS = 8
B_Q_RANK = 256
B_KV_RANK = 256
B_NOPE = 64
B_ROPE = 64
B_V = 64

C_GROUPS = 4
C_GROUP_W = 128
C_WINDOWS = (2, 4, 8, 16)

D_HEADS = 8
D_KV_HEADS = 2
D_HEAD = 64
D_WINDOW = 128
D_BLOCK = 128

P_HEADS = 8
P_NKEYS = 128
P_EXPERTS = P_NKEYS * P_NKEYS
P_QDIM = 256
P_TOPK = 16
P_TOKEN_BLOCK = 128

EVEN_SPLIT = (A_HEADS * A_DK, A_HEADS * A_DK, A_HEADS * A_DV, A_HEADS * A_DV, A_GATE_RANK, A_GATE_RANK, B_Q_RANK, B_KV_RANK, B_ROPE)
EVEN_IN = sum(EVEN_SPLIT)
EVEN_MIX = A_HEADS * A_DV + B_HEADS * B_V
ODD_SPLIT = (C_GROUPS * C_GROUP_W, D_HEADS * D_HEAD, D_KV_HEADS * D_HEAD, D_KV_HEADS * D_HEAD)
ODD_IN = sum(ODD_SPLIT)
ODD_MIX = C_GROUPS * C_GROUP_W + D_HEADS * D_HEAD

kernel_name = 'hybrid_diffusion_prefix_trunk_step'


def split_cols(x, sizes):
    return jnp.split(x, np.cumsum(sizes)[:-1].tolist(), axis=-1)


def rms_norm(x, g):
    xf = x.astype(jnp.float32)
    y = xf * lax.rsqrt(jnp.mean(xf * xf, axis=-1, keepdims=True) + EPS)
    return (y * g.astype(jnp.float32)).astype(x.dtype)


def ada_mod(cond, w, b):
    m = jax.nn.silu(cond) @ w + b
    return jnp.split(m[..., None, :], 6, axis=-1)


def modulate(x, g, shift, scale):
    return rms_norm(x, g) * (1.0 + scale) + shift


def axial_rope(rows, rot_dim):
    quarter = rot_dim // 4
    inv = ROPE_BASE ** (-jnp.arange(quarter, dtype=jnp.float32) / quarter)
    row = jnp.repeat(jnp.arange(rows, dtype=jnp.float32), GRID_W)
    col = jnp.tile(jnp.arange(GRID_W, dtype=jnp.float32), rows)
    ar = row[:, None] * inv
    ac = col[:, None] * inv
    ang = jnp.concatenate([ar, ar, ac, ac], axis=-1)
    return jnp.cos(ang), jnp.sin(ang)


def rope_last(x, cos, sin):
    r = cos.shape[-1]
    xa, xr = x[..., :-r], x[..., -r:]
    q4 = r // 4
    x4 = xr.reshape(xr.shape[:-1] + (2, 2, q4))
    rot = jnp.stack([-x4[..., 1, :], x4[..., 0, :]], axis=-2).reshape(xr.shape)
    c = cos[None, :, None, :].astype(x.dtype)
    s = sin[None, :, None, :].astype(x.dtype)
    return jnp.concatenate([xa, xr * c + rot * s], axis=-1)


def gla_log_decay(low, w_up, b_up):
    bsz, t, _ = low.shape
    z = (low @ w_up + b_up).astype(jnp.float32)
    return (jax.nn.log_sigmoid(z) / A_GATE_TAU).reshape(bsz, t, A_HEADS, A_DK)


def gla_chunked(q, k, v, log_a, s0):
    bsz, t, h, dk = q.shape
    dv = v.shape[-1]
    n, l = t // A_CHUNK, A_CHUNK
    f32 = jnp.float32
    qc = q.reshape(bsz, n, l, h, dk).astype(f32)
    kc = k.reshape(bsz, n, l, h, dk).astype(f32)
    vc = v.reshape(bsz, n, l, h, dv).astype(f32)
    b = jnp.cumsum(log_a.reshape(bsz, n, l, h, dk).astype(f32), axis=2)
    b_last = b[:, :, -1]
    q_dec = qc * jnp.exp(b)
    k_intra = kc * jnp.exp(-b)
    k_state = kc * jnp.exp(b_last[:, :, None] - b)
    lower = jnp.tril(jnp.ones((l, l), dtype=bool))
    att = jnp.where(lower, jnp.einsum('bnihd,bnjhd->bnhij', q_dec, k_intra), 0.0)
    o_intra = jnp.einsum('bnhij,bnjhv->bnihv', att, vc)
    upd = jnp.einsum('bnjhd,bnjhv->bnhdv', k_state, vc)
    decay = jnp.exp(b_last)

    def step(s, inp):
        d, u = inp
        return d[..., None] * s + u, s

    s_fin, s_start = lax.scan(step, s0.astype(f32), (jnp.moveaxis(decay, 1, 0), jnp.moveaxis(upd, 1, 0)))
    o_inter = jnp.einsum('bnihd,bnhdv->bnihv', q_dec, jnp.moveaxis(s_start, 0, 1))
    o = (o_intra + o_inter).reshape(bsz, t, h, dv)
    return o.astype(v.dtype), s_fin.astype(s0.dtype)


def gla_bidir(q, k, v, la_f, la_b, s0_f, s0_b):
    o_f, s_f = gla_chunked(q, k, v, la_f, s0_f)
    flip = lambda a: jnp.flip(a, axis=1)
    o_b, s_b = gla_chunked(flip(q), flip(k), flip(v), flip(la_b), s0_b)
    return o_f + flip(o_b), s_f, s_b


def attn_blocked(q, k, v, sink):
    bsz, t, hk, g, dq = q.shape
    nb = t // ATTN_Q_BLOCK
    scale = dq ** -0.5
    s_len = k.shape[1]
    qb = jnp.moveaxis(q.reshape(bsz, nb, ATTN_Q_BLOCK, hk, g, dq), 1, 0)

    def one(qi):
        s = jnp.einsum('bqkgd,bskd->bkgqs', qi, k).astype(jnp.float32) * scale
        if sink is not None:
            sk = jnp.broadcast_to(sink.astype(jnp.float32)[None, :, :, None, None], s.shape[:-1] + (1,))
            s = jnp.concatenate([s, sk], axis=-1)
        p = jax.nn.softmax(s, axis=-1)[..., :s_len]
        return jnp.einsum('bkgqs,bskd->bqkgd', p.astype(v.dtype), v)

    o = lax.map(one, qb)
    return jnp.moveaxis(o, 0, 1).reshape(bsz, t, hk * g * v.shape[-1])


def window_attn(q, k, v, k_ctx, v_ctx, sink):
    bsz, t, hk, g, d = q.shape
    nb = t // D_BLOCK
    span = D_BLOCK + 2 * D_WINDOW
    p_len = k_ctx.shape[1]
    padw = ((0, 0), (D_WINDOW, D_WINDOW), (0, 0), (0, 0))
    kp = jnp.pad(k, padw)
    vp = jnp.pad(v, padw)
    scale = d ** -0.5
    sk = sink.astype(jnp.float32)[None, :, :, None, None]

    def one(bi):
        start = bi * D_BLOCK
        qi = lax.dynamic_slice_in_dim(q, start, D_BLOCK, axis=1)
        ki = lax.dynamic_slice_in_dim(kp, start, span, axis=1)
        vi = lax.dynamic_slice_in_dim(vp, start, span, axis=1)
        qpos = start + jnp.arange(D_BLOCK)
        kpos = start - D_WINDOW + jnp.arange(span)
        valid = (jnp.abs(qpos[:, None] - kpos[None, :]) <= D_WINDOW) & (kpos >= 0)[None, :] & (kpos < t)[None, :]
        s_loc = jnp.einsum('bqkgd,bskd->bkgqs', qi, ki).astype(jnp.float32) * scale
        s_loc = jnp.where(valid, s_loc, NEG_INF)
        s_ctx = jnp.einsum('bqkgd,bpkd->bkgqp', qi, k_ctx).astype(jnp.float32) * scale
        s = jnp.concatenate([s_loc, s_ctx, jnp.broadcast_to(sk, s_loc.shape[:-1] + (1,))], axis=-1)
        p = jax.nn.softmax(s, axis=-1)
        o = jnp.einsum('bkgqs,bskd->bqkgd', p[..., :span].astype(v.dtype), vi)
        return o + jnp.einsum('bkgqp,bpkd->bqkgd', p[..., span:span + p_len].astype(v.dtype), v_ctx)

    o = lax.map(one, jnp.arange(nb))
    return jnp.moveaxis(o, 0, 1).reshape(bsz, t, hk * g * d)


def mla_keys(c_kv, k_rope, w_uk, w_uv, g_kn):
    bsz, s, _ = c_kv.shape
    k_nope = (c_kv @ w_uk).reshape(bsz, s, B_HEADS, B_NOPE)
    k_r = jnp.broadcast_to(k_rope[:, :, None, :], (bsz, s, B_HEADS, B_ROPE)).astype(k_nope.dtype)
    k = rms_norm(jnp.concatenate([k_nope, k_r], axis=-1), g_kn)
    v = (c_kv @ w_uv).reshape(bsz, s, B_HEADS, B_V)
    return k, v


def pool_mixer(xc, w_pool, scale):
    bsz, t, _ = xc.shape
    xg = xc.reshape(bsz, t, C_GROUPS, C_GROUP_W).astype(jnp.float32)
    cs = jnp.concatenate([jnp.zeros_like(xg[:, :1]), jnp.cumsum(xg, axis=1)], axis=1)
    pos = jnp.arange(t)
    pooled = []
    for gi, w in enumerate(C_WINDOWS):
        lo = jnp.clip(pos - w // 2, 0, t)
        hi = jnp.clip(pos - w // 2 + w, 0, t)
        csg = cs[:, :, gi]
        pooled.append((csg[:, hi] - csg[:, lo]) / (hi - lo).astype(jnp.float32)[None, :, None])
    y = jnp.stack(pooled, axis=2) - xg
    y = jnp.einsum('btgc,gcd->btgd', y, w_pool.astype(jnp.float32))
    return (y.reshape(bsz, t, C_GROUPS * C_GROUP_W) * scale).astype(xc.dtype)


def peer_ffn(h, wq, subkeys, u_tab, v_tab):
    bsz, t, d = h.shape
    x = h.reshape(-1, P_TOKEN_BLOCK, d)

    def one(xb):
        nt = xb.shape[0]
        q = (xb @ wq).reshape(nt, P_HEADS, 2, P_QDIM // 2)
        s = jnp.einsum('thcd,hckd->thck', q, subkeys).astype(jnp.float32)
        s1, i1 = lax.top_k(s[:, :, 0], P_TOPK)
        s2, i2 = lax.top_k(s[:, :, 1], P_TOPK)
        cand_s = (s1[..., :, None] + s2[..., None, :]).reshape(nt, P_HEADS, P_TOPK * P_TOPK)
        cand_i = (i1[..., :, None] * P_NKEYS + i2[..., None, :]).reshape(nt, P_HEADS, P_TOPK * P_TOPK)
        top_s, pos = lax.top_k(cand_s, P_TOPK)
        idx = jnp.take_along_axis(cand_i, pos, axis=-1)
        gate = jax.nn.softmax(top_s, axis=-1).astype(xb.dtype)
        u = jnp.take(u_tab, idx, axis=0)
        act = jax.nn.gelu(jnp.einsum('thkd,td->thk', u, xb), approximate=False) * gate
        vv = jnp.take(v_tab, idx, axis=0)
        return jnp.einsum('thk,thkd->td', act, vv)

    return lax.map(one, x).reshape(bsz, t, d)


def even_mixer(h, p, ctx, rope):
    (w_in, w_gu, b_gu, g_go, g_cq, g_ckv, w_uq, w_uk, w_uv, g_qn, g_kn, w_out) = p
    bsz, t, _ = h.shape
    qa, ka, va, ra, glf, glb, cq, ckv_raw, kr = split_cols(h @ w_in, EVEN_SPLIT)
    qa = qa.reshape(bsz, t, A_HEADS, A_DK) * (A_DK ** -0.5)
    ka = ka.reshape(bsz, t, A_HEADS, A_DK)
    va = va.reshape(bsz, t, A_HEADS, A_DV)
    la_f = gla_log_decay(glf, w_gu[0], b_gu[0])
    la_b = gla_log_decay(glb, w_gu[1], b_gu[1])
    if ctx is None:
        s0_f = jnp.zeros((bsz, A_HEADS, A_DK, A_DV), h.dtype)
        s0_b = s0_f
    else:
        s0_f, s0_b, ckv_ctx, kr_ctx = ctx
    oa, s_f, s_b = gla_bidir(qa, ka, va, la_f, la_b, s0_f, s0_b)
    oa = rms_norm(oa, g_go) * jax.nn.silu(ra).reshape(bsz, t, A_HEADS, A_DV)
    c_kv = rms_norm(ckv_raw, g_ckv)
    qb = (rms_norm(cq, g_cq) @ w_uq).reshape(bsz, t, B_HEADS, B_NOPE + B_ROPE)
    qb = rms_norm(qb, g_qn)
    kb, vb = mla_keys(c_kv, kr, w_uk, w_uv, g_kn)
    if ctx is None:
        new_ctx = (s_f, s_b, c_kv, kr)
    else:
        cos, sin = rope
        qb = rope_last(qb, cos, sin)
        kb = rope_last(kb, cos, sin)
        kc, vc = mla_keys(ckv_ctx, kr_ctx, w_uk, w_uv, g_kn)
        kb = jnp.concatenate([kb, kc], axis=1)
        vb = jnp.concatenate([vb, vc], axis=1)
        new_ctx = None
    ob = attn_blocked(qb[:, :, :, None, :], kb, vb, None)
    out = jnp.concatenate([oa.reshape(bsz, t, A_HEADS * A_DV), ob], axis=-1) @ w_out
    return out, new_ctx


def odd_mixer(h, p, ctx, rope):
    (w_in, w_pool, p_scale, g_qn, g_kn, sink, w_out) = p
    bsz, t, _ = h.shape
    g = D_HEADS // D_KV_HEADS
    xc, qd, kd, vd = split_cols(h @ w_in, ODD_SPLIT)
    oc = pool_mixer(xc, w_pool, p_scale)
    q = rms_norm(qd.reshape(bsz, t, D_HEADS, D_HEAD), g_qn)
    k = rms_norm(kd.reshape(bsz, t, D_KV_HEADS, D_HEAD), g_kn)
    v = vd.reshape(bsz, t, D_KV_HEADS, D_HEAD)
    sink_g = sink.reshape(D_KV_HEADS, g)
    if ctx is None:
        od = attn_blocked(q.reshape(bsz, t, D_KV_HEADS, g, D_HEAD), k, v, sink_g)
        new_ctx = (k, v)
    else:
        k_ctx, v_ctx = ctx
        cos, sin = rope
        q = rope_last(q, cos, sin)
        k = rope_last(k, cos, sin)
        od = window_attn(q.reshape(bsz, t, D_KV_HEADS, g, D_HEAD), k, v, k_ctx, v_ctx, sink_g)
        new_ctx = None
    out = jnp.concatenate([oc, od], axis=-1) @ w_out
    return out, new_ctx


def setup_inputs(seed: int = 0) -> dict:
    key = jax.random.key(seed)
    ks = iter(jax.random.split(key, 40))
    nrm = lambda shape, s: jax.random.normal(next(ks), shape, jnp.float32) * s
    gain = lambda shape: 1.0 + 0.05 * jax.random.normal(next(ks), shape, jnp.float32)
    d = D_MODEL
    sd = d ** -0.5
    return {
        'x_prompt': nrm((BATCH, SEQ, d), 1.0),
        'x_sample': nrm((DEC_BATCH, DEC_SEQ, d), 1.0),
        'state_gla': nrm((DEC_BATCH, N_EVEN, 2, A_HEADS, A_DK, A_DV), 1.0),
        'cache_mla_ckv': nrm((DEC_BATCH, N_EVEN, PAST_LEN, B_KV_RANK), 1.0),
        'cache_mla_krope': nrm((DEC_BATCH, N_EVEN, PAST_LEN, B_ROPE), 1.0),
        'cache_win_kv': nrm((DEC_BATCH, N_ODD, 2, PAST_LEN, D_KV_HEADS, D_HEAD), 1.0),
        'c': nrm((DEC_BATCH, d), 1.0),
        'c_ctx': nrm((d,), 1.0),
        'g_norm': gain((DEPTH, 2, d)),
        'w_ada': nrm((DEPTH, d, 6 * d), 0.5 * sd),
        'b_ada': nrm((DEPTH, 6 * d), 0.02),
        'w_in_even': nrm((N_EVEN, d, EVEN_IN), sd),
        'w_gate_up': nrm((N_EVEN, 2, A_GATE_RANK, A_HEADS * A_DK), A_GATE_RANK ** -0.5),
        'b_gate_up': nrm((N_EVEN, 2, A_HEADS * A_DK), 0.1),
        'g_gla_out': gain((N_EVEN, A_DV)),
        'g_mla_cq': gain((N_EVEN, B_Q_RANK)),
        'g_mla_ckv': gain((N_EVEN, B_KV_RANK)),
        'w_mla_uq': nrm((N_EVEN, B_Q_RANK, B_HEADS * (B_NOPE + B_ROPE)), B_Q_RANK ** -0.5),
        'w_mla_uk': nrm((N_EVEN, B_KV_RANK, B_HEADS * B_NOPE), B_KV_RANK ** -0.5),
        'w_mla_uv': nrm((N_EVEN, B_KV_RANK, B_HEADS * B_V), B_KV_RANK ** -0.5),
        'g_mla_qn': gain((N_EVEN, B_NOPE + B_ROPE)),
        'g_mla_kn': gain((N_EVEN, B_NOPE + B_ROPE)),
        'w_out_even': nrm((N_EVEN, EVEN_MIX, d), EVEN_MIX ** -0.5),
        'w_in_odd': nrm((N_ODD, d, ODD_IN), sd),
        'w_pool': nrm((N_ODD, C_GROUPS, C_GROUP_W, C_GROUP_W), C_GROUP_W ** -0.5),
        'pool_scale': gain((N_ODD, C_GROUPS * C_GROUP_W)),
        'g_win_qn': gain((N_ODD, D_HEAD)),
        'g_win_kn': gain((N_ODD, D_HEAD)),
        'win_sink': nrm((N_ODD, D_HEADS), 0.5),
        'w_out_odd': nrm((N_ODD, ODD_MIX, d), ODD_MIX ** -0.5),
        'peer_wq': nrm((DEPTH, d, P_HEADS * P_QDIM), sd),
        'peer_subkeys': nrm((DEPTH, P_HEADS, 2, P_NKEYS, P_QDIM // 2), (P_QDIM // 2) ** -0.5),
        'peer_u': nrm((DEPTH, P_EXPERTS, d), sd),
        'peer_v': nrm((DEPTH, P_EXPERTS, d), (P_HEADS * P_TOPK) ** -0.5),
    }


def reference(x_prompt, x_sample, state_gla, cache_mla_ckv, cache_mla_krope, cache_win_kv, c, c_ctx,
              g_norm, w_ada, b_ada, w_in_even, w_gate_up, b_gate_up, g_gla_out, g_mla_cq, g_mla_ckv,
              w_mla_uq, w_mla_uk, w_mla_uv, g_mla_qn, g_mla_kn, w_out_even, w_in_odd, w_pool, pool_scale,
              g_win_qn, g_win_kn, win_sink, w_out_odd, peer_wq, peer_subkeys, peer_u, peer_v):
    rows = x_sample.shape[1] // GRID_W
    rope_b = axial_rope(rows, B_ROPE)
    rope_d = axial_rope(rows, D_HEAD)
    xp, xs = x_prompt, x_sample
    gla_states, mla_ckv, mla_kr, win_kv = [], [], [], []
    for l in range(DEPTH):
        sh1p, sc1p, gt1p, sh2p, sc2p, gt2p = ada_mod(c_ctx, w_ada[l], b_ada[l])
        sh1s, sc1s, gt1s, sh2s, sc2s, gt2s = ada_mod(c, w_ada[l], b_ada[l])
        hp = modulate(xp, g_norm[l, 0], sh1p, sc1p)
        hs = modulate(xs, g_norm[l, 0], sh1s, sc1s)
        if l % 2 == 0:
            e = l // 2
            pe = (w_in_even[e], w_gate_up[e], b_gate_up[e], g_gla_out[e], g_mla_cq[e], g_mla_ckv[e],
                  w_mla_uq[e], w_mla_uk[e], w_mla_uv[e], g_mla_qn[e], g_mla_kn[e], w_out_even[e])
            mp, (s_f, s_b, ckv_p, kr_p) = even_mixer(hp, pe, None, None)
            ctx_s = (state_gla[:, e, 0], state_gla[:, e, 1], cache_mla_ckv[:, e], cache_mla_krope[:, e])
            ms, _ = even_mixer(hs, pe, ctx_s, rope_b)
            gla_states.append(jnp.stack([s_f, s_b], axis=1))
            mla_ckv.append(ckv_p)
            mla_kr.append(kr_p)
        else:
            o = l // 2
            po = (w_in_odd[o], w_pool[o], pool_scale[o], g_win_qn[o], g_win_kn[o], win_sink[o], w_out_odd[o])
            mp, (k_p, v_p) = odd_mixer(hp, po, None, None)
            ms, _ = odd_mixer(hs, po, (cache_win_kv[:, o, 0], cache_win_kv[:, o, 1]), rope_d)
            win_kv.append(jnp.stack([k_p, v_p], axis=1))
        xp = xp + gt1p * mp
        xs = xs + gt1s * ms
        hp = modulate(xp, g_norm[l, 1], sh2p, sc2p)
        hs = modulate(xs, g_norm[l, 1], sh2s, sc2s)
        xp = xp + gt2p * peer_ffn(hp, peer_wq[l], peer_subkeys[l], peer_u[l], peer_v[l])
        xs = xs + gt2s * peer_ffn(hs, peer_wq[l], peer_subkeys[l], peer_u[l], peer_v[l])
    state_gla_new = jnp.stack(gla_states, axis=1)
    cache_mla_ckv_new = jnp.stack(mla_ckv, axis=1)
    cache_mla_krope_new = jnp.stack(mla_kr, axis=1)
    cache_win_kv_new = jnp.stack(win_kv, axis=1)
    return (xp, xs, state_gla_new, cache_mla_ckv_new, cache_mla_krope_new, cache_win_kv_new)
```

```cpp
#include <hip/hip_runtime.h>
#include <hip/hip_cooperative_groups.h>
#include <cstdio>
#include <cstdint>
namespace cg = cooperative_groups;

#ifndef DUP_KIND
#define DUP_KIND 0
#endif
#ifndef N_LAUNCH_PER_PHASE
#define N_LAUNCH_PER_PHASE 0
#endif

#define DEV __device__ __forceinline__
typedef unsigned short bf16_t;
typedef __attribute__((ext_vector_type(4))) float f32x4;
typedef __attribute__((ext_vector_type(8))) __bf16 bf16x8;
typedef __attribute__((ext_vector_type(4))) unsigned u32x4;
typedef __attribute__((ext_vector_type(2))) unsigned u32x2;
DEV u32x4 mk4(unsigned a, unsigned b, unsigned c, unsigned d) { u32x4 r; r.x = a; r.y = b; r.z = c; r.w = d; return r; }

DEV float bf2f(bf16_t v) { return __uint_as_float(((unsigned)v) << 16); }
typedef __attribute__((ext_vector_type(2))) __bf16 bf16x2_t;
DEV unsigned pack2(float a, float b) { bf16x2_t v = {(__bf16)a, (__bf16)b}; return __builtin_bit_cast(unsigned, v); }
DEV unsigned f2bf_u(float f) { return pack2(f, 0.f) & 0xffffu; }
DEV float lo2f(unsigned w) { return __uint_as_float(w << 16); }
DEV float hi2f(unsigned w) { return __uint_as_float(w & 0xffff0000u); }
DEV f32x4 mfma16(u32x4 a, u32x4 b, f32x4 c) {
  return __builtin_amdgcn_mfma_f32_16x16x32_bf16(__builtin_bit_cast(bf16x8, a), __builtin_bit_cast(bf16x8, b), c, 0, 0, 0);
}
DEV u32x2 pack4(f32x4 v) { u32x2 r; r.x = pack2(v[0], v[1]); r.y = pack2(v[2], v[3]); return r; }

constexpr int TP = 8192, TT = 24576;
constexpr float EPS = 1e-6f;
constexpr size_t OUT_GLA = 25165824, OUT_CKV = 29360128, OUT_KR = 33554432, OUT_WIN = 34603008;

constexpr size_t AL(size_t x) { return (x + 255) & ~size_t(255); }
constexpr size_t OFF_CTR  = 0;
constexpr size_t OFF_BAR  = 256;
constexpr size_t OFF_MOD  = 256 + 3456 * 4;
constexpr size_t OFF_ROPE = OFF_MOD + AL(4 * 5 * 6144 * 4);
constexpr size_t OFF_WINE = OFF_ROPE + AL(2 * 1024 * 4);
constexpr size_t OFF_WUQ  = OFF_WINE + AL((size_t)2 * 2176 * 1024 * 2);
constexpr size_t OFF_WUK  = OFF_WUQ + AL((size_t)2 * 1024 * 256 * 2);
constexpr size_t OFF_WUV  = OFF_WUK + AL((size_t)2 * 512 * 256 * 2);
constexpr size_t OFF_WOE  = OFF_WUV + AL((size_t)2 * 512 * 256 * 2);
constexpr size_t OFF_WINO = OFF_WOE + AL((size_t)2 * 1024 * 1024 * 2);
constexpr size_t OFF_WPOOL= OFF_WINO + AL((size_t)2 * 1280 * 1024 * 2);
constexpr size_t OFF_WOO  = OFF_WPOOL + AL((size_t)8 * 128 * 128 * 2);
constexpr size_t OFF_WQ   = OFF_WOO + AL((size_t)2 * 1024 * 1024 * 2);
constexpr size_t OFF_SK   = OFF_WQ + AL((size_t)4 * 2048 * 1024 * 2);
constexpr size_t OFF_U    = OFF_SK + AL((size_t)4 * 8 * 2 * 128 * 128 * 2);
constexpr size_t OFF_V    = OFF_U + AL((size_t)4 * 16384 * 1024);
constexpr size_t OFF_USC  = OFF_V + AL((size_t)4 * 16384 * 1024);
constexpr size_t OFF_VSC  = OFF_USC + AL((size_t)4 * 16384 * 4);
constexpr size_t OFF_H    = OFF_VSC + AL((size_t)4 * 16384 * 4);
constexpr size_t OFF_PROJ = OFF_H + AL((size_t)TT * 1024 * 2);
constexpr size_t OFF_RAW  = OFF_PROJ + AL((size_t)TT * 1568 * 2);
constexpr size_t OFF_CQN  = OFF_RAW + AL((size_t)TT * 576 * 4);
constexpr size_t OFF_CKVN = OFF_CQN + AL((size_t)TT * 256 * 2);
constexpr size_t OFF_QB   = OFF_CKVN + AL((size_t)(TT + 2048) * 256 * 2);
constexpr size_t OFF_KS   = OFF_QB + AL((size_t)TT * 1024 * 2);
constexpr size_t OFF_KP   = OFF_KS + AL((size_t)4 * 4608 * 1024 * 2);
constexpr size_t OFF_VTS  = OFF_KP + AL((size_t)32 * 256 * 1024 * 2);
constexpr size_t OFF_VTP  = OFF_VTS + AL((size_t)4 * 8 * 64 * 4608 * 2);
constexpr size_t OFF_ODIR = OFF_VTP + AL((size_t)32 * 8 * 64 * 256 * 2);
constexpr size_t OFF_MIX  = OFF_ODIR + AL((size_t)2 * TT * 512 * 4);
constexpr size_t OFF_SELI = OFF_MIX + AL((size_t)TT * 1024 * 2);
constexpr size_t OFF_SELG = OFF_SELI + AL((size_t)TT * 128 * 4);
constexpr size_t OFF_QDG  = OFF_SELG + AL((size_t)TT * 128 * 4);
constexpr size_t OFF_KSTG = OFF_QDG + AL((size_t)3072 * 4096 * 2);
constexpr size_t OFF_DECG = OFF_KSTG + AL((size_t)3072 * 4096 * 2);
constexpr size_t OFF_VTG  = OFF_DECG + AL((size_t)3072 * 64 * 4);
constexpr size_t OFF_OINT = OFF_VTG + AL((size_t)1536 * 8192 * 2);
constexpr size_t OFF_H8   = OFF_OINT + AL((size_t)2 * TT * 512 * 4);
constexpr size_t OFF_HSC  = OFF_H8 + AL((size_t)TT * 1024);
constexpr size_t WS_END   = OFF_HSC + AL((size_t)TT * 4);

constexpr int LDS_BYTES = 75776;
constexpr int NPHASES = 36;

struct P { const float* in[34]; float* out; unsigned char* ws; int ph_lo, ph_hi; };
DEV int TID() { int t = (int)__builtin_amdgcn_workitem_id_x(); asm volatile("" : "+v"(t)); return t; }
#define GAS __attribute__((address_space(1)))
DEV unsigned char* WS(const P& p) { size_t z = 0; asm volatile("" : "+s"(z)); return p.ws + z; }
DEV const float* IN(const P& p, int i) { return (const float*)(GAS const float*)p.in[i]; }
DEV float* OUT(const P& p) { return (float*)(GAS float*)p.out; }

enum { I_XP = 0, I_XS, I_SGLA, I_CCKV, I_CKR, I_CWIN, I_C, I_CCTX, I_GNORM, I_WADA, I_BADA, I_WINE, I_WGU, I_BGU, I_GGO, I_GCQ, I_GCKV,
       I_WUQ, I_WUK, I_WUV, I_GQN, I_GKN, I_WOE, I_WINO, I_WPOOL, I_PSCALE, I_GWQN, I_GWKN, I_SINK, I_WOO, I_PWQ, I_PSK, I_PU, I_PV };

DEV int cond_of(int tok) { return tok < TP ? 0 : 1 + ((tok - TP) >> 12); }

DEV void transpose_cvt(const float* __restrict__ src, bf16_t* __restrict__ dst, int K, int N, unsigned char* smem) {
  float (*t)[33] = (float (*)[33])smem;
  const int tid = TID();
  const int nN = N >> 5, ntile = (K >> 6) * nN;
  for (int tile = blockIdx.x; tile < ntile; tile += gridDim.x) {
    const int k0 = (tile / nN) << 6, n0 = (tile % nN) << 5;
    __syncthreads();
#pragma unroll
    for (int i = 0; i < 2; i++) {
      int k = (tid >> 3) + 32 * i, n4 = (tid & 7) * 4;
      float4 v = *(const float4*)(src + (size_t)(k0 + k) * N + n0 + n4);
      t[k][n4] = v.x; t[k][n4 + 1] = v.y; t[k][n4 + 2] = v.z; t[k][n4 + 3] = v.w;
    }
    __syncthreads();
    int n = tid >> 3, k8 = (tid & 7) * 8;
    u32x4 o;
    o.x = pack2(t[k8][n], t[k8 + 1][n]); o.y = pack2(t[k8 + 2][n], t[k8 + 3][n]);
    o.z = pack2(t[k8 + 4][n], t[k8 + 5][n]); o.w = pack2(t[k8 + 6][n], t[k8 + 7][n]);
    *(u32x4*)(dst + (size_t)(n0 + n) * K + k0 + k8) = o;
  }
}

DEV void cvt_bf16(const float* __restrict__ src, bf16_t* __restrict__ dst, size_t n8) {
  for (size_t i = (size_t)blockIdx.x * 256 + TID(); i < n8; i += (size_t)gridDim.x * 256) {
    float4 a = *(const float4*)(src + i * 8), b = *(const float4*)(src + i * 8 + 4);
    u32x4 o; o.x = pack2(a.x, a.y); o.y = pack2(a.z, a.w); o.z = pack2(b.x, b.y); o.w = pack2(b.z, b.w);
    *(u32x4*)(dst + i * 8) = o;
  }
}

DEV void cvt_fp8_rows(const float* __restrict__ src, unsigned char* __restrict__ dst, float* __restrict__ scales, int nrows) {
  const int lane = TID() & 63, wave = TID() >> 6;
  for (int row0 = (blockIdx.x * 4 + wave) * 4; row0 < nrows; row0 += gridDim.x * 16) {
    f32x4 v[4][4];
#pragma unroll
    for (int r = 0; r < 4; r++)
#pragma unroll
      for (int i = 0; i < 4; i++) v[r][i] = *(const f32x4*)(src + (size_t)(row0 + r) * 1024 + lane * 16 + i * 4);
#pragma unroll
    for (int r = 0; r < 4; r++) {
      float am = 0.f;
#pragma unroll
      for (int i = 0; i < 4; i++)
#pragma unroll
        for (int j = 0; j < 4; j++) am = fmaxf(am, fabsf(v[r][i][j]));
#pragma unroll
      for (int o = 32; o >= 1; o >>= 1) am = fmaxf(am, __shfl_xor(am, o));
      const float sc = am > 0.f ? 440.f / am : 1.f;
      unsigned w[4];
#pragma unroll
      for (int i = 0; i < 4; i++) {
        int t = 0;
        t = __builtin_amdgcn_cvt_pk_fp8_f32(v[r][i][0] * sc, v[r][i][1] * sc, t, false);
        t = __builtin_amdgcn_cvt_pk_fp8_f32(v[r][i][2] * sc, v[r][i][3] * sc, t, true);
        w[i] = (unsigned)t;
      }
      *(u32x4*)(dst + (size_t)(row0 + r) * 1024 + lane * 16) = mk4(w[0], w[1], w[2], w[3]);
      if (lane == 0) scales[row0 + r] = am > 0.f ? am / 440.f : 1.f;
    }
  }
}

DEV void phase_prologue(const P& p, unsigned char* smem) {
  const int tid = TID();
  unsigned char* ws = WS(p);
  if (blockIdx.x == 0) {
    float* rt = (float*)(ws + OFF_ROPE);
    for (int i = tid; i < 1024; i += 256) {
      int pos = i >> 4, f = i & 15;
      float inv = powf(10000.f, -(float)f / 16.f);
      float ang = (float)pos * inv;
      rt[i] = cosf(ang); rt[1024 + i] = sinf(ang);
    }
  }
  {
    float* red = (float*)smem;
    float* mod = (float*)(ws + OFF_MOD);
    const int col = tid & 63, kq = tid >> 6;
    for (int tile = blockIdx.x; tile < 4 * 96; tile += gridDim.x) {
      const int l = tile / 96, c0 = (tile % 96) * 64;
      const float* w = IN(p, I_WADA) + (size_t)l * 1024 * 6144 + c0 + col;
      float a0 = 0, a1 = 0, a2 = 0, a3 = 0, a4 = 0;
#pragma unroll 8
      for (int k = kq * 256; k < kq * 256 + 256; k++) {
        float wv = w[(size_t)k * 6144];
        float c0v = IN(p, I_CCTX)[k], c1 = IN(p, I_C)[k], c2 = IN(p, I_C)[1024 + k], c3 = IN(p, I_C)[2048 + k], c4 = IN(p, I_C)[3072 + k];
        a0 += c0v / (1.f + __expf(-c0v)) * wv; a1 += c1 / (1.f + __expf(-c1)) * wv; a2 += c2 / (1.f + __expf(-c2)) * wv;
        a3 += c3 / (1.f + __expf(-c3)) * wv; a4 += c4 / (1.f + __expf(-c4)) * wv;
      }
      __syncthreads();
      red[(kq * 5 + 0) * 64 + col] = a0; red[(kq * 5 + 1) * 64 + col] = a1; red[(kq * 5 + 2) * 64 + col] = a2;
      red[(kq * 5 + 3) * 64 + col] = a3; red[(kq * 5 + 4) * 64 + col] = a4;
      __syncthreads();
      for (int i = tid; i < 320; i += 256) {
        int cd = i >> 6, cc = i & 63;
        float s = red[(0 * 5 + cd) * 64 + cc] + red[(1 * 5 + cd) * 64 + cc] + red[(2 * 5 + cd) * 64 + cc] + red[(3 * 5 + cd) * 64 + cc];
        mod[(size_t)(l * 5 + cd) * 6144 + c0 + cc] = s + IN(p, I_BADA)[l * 6144 + c0 + cc];
      }
    }
    __syncthreads();
  }
  for (int j = 0; j < 26; j++) {
    const float* src; bf16_t* dst; int K, N;
    if (j < 2)       { src = IN(p, I_WINE) + (size_t)j * 1024 * 2144; dst = (bf16_t*)(ws + OFF_WINE) + (size_t)j * 2176 * 1024; K = 1024; N = 2144; }
    else if (j < 4)  { int e = j - 2; src = IN(p, I_WUQ) + (size_t)e * 256 * 1024; dst = (bf16_t*)(ws + OFF_WUQ) + (size_t)e * 1024 * 256; K = 256; N = 1024; }
    else if (j < 6)  { int e = j - 4; src = IN(p, I_WUK) + (size_t)e * 256 * 512; dst = (bf16_t*)(ws + OFF_WUK) + (size_t)e * 512 * 256; K = 256; N = 512; }
    else if (j < 8)  { int e = j - 6; src = IN(p, I_WUV) + (size_t)e * 256 * 512; dst = (bf16_t*)(ws + OFF_WUV) + (size_t)e * 512 * 256; K = 256; N = 512; }
    else if (j < 10) { int e = j - 8; src = IN(p, I_WOE) + (size_t)e * 1024 * 1024; dst = (bf16_t*)(ws + OFF_WOE) + (size_t)e * 1024 * 1024; K = 1024; N = 1024; }
    else if (j < 12) { int o = j - 10; src = IN(p, I_WINO) + (size_t)o * 1024 * 1280; dst = (bf16_t*)(ws + OFF_WINO) + (size_t)o * 1280 * 1024; K = 1024; N = 1280; }
    else if (j < 20) { int g = j - 12; src = IN(p, I_WPOOL) + (size_t)g * 16384; dst = (bf16_t*)(ws + OFF_WPOOL) + (size_t)g * 16384; K = 128; N = 128; }
    else if (j < 22) { int o = j - 20; src = IN(p, I_WOO) + (size_t)o * 1024 * 1024; dst = (bf16_t*)(ws + OFF_WOO) + (size_t)o * 1024 * 1024; K = 1024; N = 1024; }
    else             { int l = j - 22; src = IN(p, I_PWQ) + (size_t)l * 1024 * 2048; dst = (bf16_t*)(ws + OFF_WQ) + (size_t)l * 2048 * 1024; K = 1024; N = 2048; }
    transpose_cvt(src, dst, K, N, smem);
  }
  for (int i = blockIdx.x * 256 + tid; i < 2 * 32 * 1024 / 8; i += gridDim.x * 256) {
    int e = i / (32 * 128), r = i % (32 * 128);
    *(u32x4*)((bf16_t*)(ws + OFF_WINE) + ((size_t)e * 2176 + 2144) * 1024 + (size_t)r * 8) = mk4(0, 0, 0, 0);
  }
  cvt_bf16(IN(p, I_PSK), (bf16_t*)(ws + OFF_SK), (size_t)4 * 8 * 2 * 128 * 128 / 8);
  cvt_fp8_rows(IN(p, I_PU), ws + OFF_U, (float*)(ws + OFF_USC), 4 * 16384);
  cvt_fp8_rows(IN(p, I_PV), ws + OFF_V, (float*)(ws + OFF_VSC), 4 * 16384);
}

DEV void phase_norm(const P& p, int l, int sub) {
  const int lane = TID() & 63, wave = TID() >> 6;
  const float* x = OUT(p);
  const float* g = IN(p, I_GNORM) + (size_t)(l * 2 + sub) * 1024;
  const float* mod = (const float*)(WS(p) + OFF_MOD);
  bf16_t* H = (bf16_t*)(WS(p) + OFF_H);
  for (int tok = blockIdx.x * 4 + wave; tok < TT; tok += gridDim.x * 4) {
    const float* xr = (l == 0 && sub == 0) ? (tok < TP ? IN(p, I_XP) + (size_t)tok * 1024 : IN(p, I_XS) + (size_t)(tok - TP) * 1024) : x + (size_t)tok * 1024;
    float4 v[4]; float ss = 0;
#pragma unroll
    for (int i = 0; i < 4; i++) { v[i] = *(const float4*)(xr + i * 256 + lane * 4); ss += v[i].x * v[i].x + v[i].y * v[i].y + v[i].z * v[i].z + v[i].w * v[i].w; }
#pragma unroll
    for (int o = 32; o >= 1; o >>= 1) ss += __shfl_xor(ss, o);
    const float rstd = rsqrtf(ss * (1.f / 1024.f) + EPS);
    const float* mb = mod + (size_t)(l * 5 + cond_of(tok)) * 6144 + sub * 3072;
    f32x4 ov[4]; float am = 0.f;
#pragma unroll
    for (int i = 0; i < 4; i++) {
      int c = i * 256 + lane * 4;
      float4 gg = *(const float4*)(g + c), sh = *(const float4*)(mb + c), sc = *(const float4*)(mb + 1024 + c);
      f32x4 o;
      o[0] = v[i].x * rstd * gg.x * (1.f + sc.x) + sh.x; o[1] = v[i].y * rstd * gg.y * (1.f + sc.y) + sh.y;
      o[2] = v[i].z * rstd * gg.z * (1.f + sc.z) + sh.z; o[3] = v[i].w * rstd * gg.w * (1.f + sc.w) + sh.w;
      *(u32x2*)(H + (size_t)tok * 1024 + c) = pack4(o);
      ov[i] = o; am = fmaxf(am, fmaxf(fmaxf(fabsf(o[0]), fabsf(o[1])), fmaxf(fabsf(o[2]), fabsf(o[3]))));
    }
    if (sub == 1) {
#pragma unroll
      for (int o = 32; o >= 1; o >>= 1) am = fmaxf(am, __shfl_xor(am, o));
      const float q = am > 0.f ? 440.f / am : 1.f;
      unsigned char* h8 = WS(p) + OFF_H8 + (size_t)tok * 1024;
#pragma unroll
      for (int i = 0; i < 4; i++) {
        int t = 0;
        t = __builtin_amdgcn_cvt_pk_fp8_f32(ov[i][0] * q, ov[i][1] * q, t, false);
        t = __builtin_amdgcn_cvt_pk_fp8_f32(ov[i][2] * q, ov[i][3] * q, t, true);
        *(int*)(h8 + i * 256 + lane * 4) = t;
      }
      if (lane == 0) ((float*)(WS(p) + OFF_HSC))[tok] = am > 0.f ? am / 440.f : 1.f;
    }
  }
}

DEV void phase_winctx(const P& p, int o) {
  bf16_t* KS = (bf16_t*)(WS(p) + OFF_KS); bf16_t* VTS = (bf16_t*)(WS(p) + OFF_VTS);
  const float* cw = IN(p, I_CWIN);
  for (int i = blockIdx.x * 256 + TID(); i < 4 * 512 * 128; i += gridDim.x * 256) {
    int d = i & 63, hk = (i >> 6) & 1, pp = (i >> 7) & 511, b = i >> 16;
    float kv = cw[((((size_t)(b * 2 + o) * 2 + 0) * 512 + pp) * 2 + hk) * 64 + d];
    float vv = cw[((((size_t)(b * 2 + o) * 2 + 1) * 512 + pp) * 2 + hk) * 64 + d];
    KS[((size_t)b * 4608 + 4096 + pp) * 128 + hk * 64 + d] = (bf16_t)f2bf_u(kv);
    VTS[((size_t)(b * 2 + hk) * 64 + d) * 4608 + 4096 + pp] = (bf16_t)f2bf_u(vv);
  }
}


template <int AMODE>
DEV void gemm_gload(u32x4 (&ra)[4], u32x4 (&rb)[4], const bf16_t* __restrict__ A, int lda, const bf16_t* __restrict__ Bt, int ldb,
                    int m0, int n0, int k0, int pg) {
  const int tid = TID();
#pragma unroll
  for (int i = 0; i < 4; i++) {
    const int c = tid + 256 * i, r = c >> 3, kc = (c & 7) * 8;
    rb[i] = *(const u32x4*)(Bt + (size_t)(n0 + r) * ldb + k0 + kc);
    if (AMODE == 0) ra[i] = *(const u32x4*)(A + (size_t)(m0 + r) * lda + k0 + kc);
    else {
      const int t = m0 + r; int sbase, pos, len;
      if (t < TP) { sbase = t & ~255; pos = t & 255; len = 256; }
      else { int tt = t - TP; sbase = TP + (tt & ~4095); pos = tt & 4095; len = 4096; }
      const int w = 2 << pg; int lo = pos - (w >> 1), hi = lo + w; lo = lo < 0 ? 0 : lo; hi = hi > len ? len : hi;
      const int ch = pg * 128 + k0 + kc;
      float s0 = 0, s1 = 0, s2 = 0, s3 = 0, s4 = 0, s5 = 0, s6 = 0, s7 = 0;
      for (int q = lo; q < hi; q++) {
        u32x4 u = *(const u32x4*)(A + (size_t)(sbase + q) * lda + ch);
        s0 += lo2f(u.x); s1 += hi2f(u.x); s2 += lo2f(u.y); s3 += hi2f(u.y);
        s4 += lo2f(u.z); s5 += hi2f(u.z); s6 += lo2f(u.w); s7 += hi2f(u.w);
      }
      const float ic = 1.f / (float)(hi - lo);
      u32x4 u = *(const u32x4*)(A + (size_t)t * lda + ch);
      u32x4 o;
      o.x = pack2(s0 * ic - lo2f(u.x), s1 * ic - hi2f(u.x)); o.y = pack2(s2 * ic - lo2f(u.y), s3 * ic - hi2f(u.y));
      o.z = pack2(s4 * ic - lo2f(u.z), s5 * ic - hi2f(u.z)); o.w = pack2(s6 * ic - lo2f(u.w), s7 * ic - hi2f(u.w));
      ra[i] = o;
    }
  }
}

DEV void gemm_lds_store(const u32x4 (&ra)[4], const u32x4 (&rb)[4], bf16_t* An, bf16_t* Bn, int tid) {
#pragma unroll
  for (int i = 0; i < 4; i++) {
    const int c = tid + 256 * i, r = c >> 3, kc = (c & 7) * 8;
    *(u32x4*)(An + r * 72 + kc) = ra[i];
    *(u32x4*)(Bn + r * 72 + kc) = rb[i];
  }
}
DEV void gemm_compute(f32x4 (&acc)[2][8], const bf16_t* Ac, const bf16_t* Bc, int wave, int l15, int quad) {
  u32x4 af0[2], bf0[8], af1[2], bf1[8];
#pragma unroll
  for (int mt = 0; mt < 2; mt++) af0[mt] = *(const u32x4*)(Ac + (wave * 32 + mt * 16 + l15) * 72 + quad * 8);
#pragma unroll
  for (int nt = 0; nt < 8; nt++) bf0[nt] = *(const u32x4*)(Bc + (nt * 16 + l15) * 72 + quad * 8);
#pragma unroll
  for (int mt = 0; mt < 2; mt++) af1[mt] = *(const u32x4*)(Ac + (wave * 32 + mt * 16 + l15) * 72 + 32 + quad * 8);
#pragma unroll
  for (int nt = 0; nt < 8; nt++) bf1[nt] = *(const u32x4*)(Bc + (nt * 16 + l15) * 72 + 32 + quad * 8);
  __builtin_amdgcn_sched_barrier(0);
#pragma unroll
  for (int nt = 0; nt < 8; nt++)
#pragma unroll
    for (int mt = 0; mt < 2; mt++) acc[mt][nt] = mfma16(bf0[nt], af0[mt], acc[mt][nt]);
#pragma unroll
  for (int nt = 0; nt < 8; nt++)
#pragma unroll
    for (int mt = 0; mt < 2; mt++) acc[mt][nt] = mfma16(bf1[nt], af1[mt], acc[mt][nt]);
  __builtin_amdgcn_sched_barrier(0);
}

template <int AMODE>
DEV void gemm_main(f32x4 (&acc)[2][8], const bf16_t* __restrict__ A, int lda, const bf16_t* __restrict__ Bt, int ldb,
                   int K, int m0, int n0, unsigned char* smem, int pg) {
  const int tid = TID(), lane = tid & 63, wave = tid >> 6, l15 = lane & 15, quad = lane >> 4;
  bf16_t* A0 = (bf16_t*)smem; bf16_t* B0 = A0 + 128 * 72; bf16_t* A1 = A0 + 2 * 128 * 72; bf16_t* B1 = B0 + 2 * 128 * 72;
#pragma unroll
  for (int i = 0; i < 2; i++)
#pragma unroll
    for (int j = 0; j < 8; j++) acc[i][j] = (f32x4){0.f, 0.f, 0.f, 0.f};
  u32x4 ra0[4], rb0[4], ra1[4], rb1[4];
  const int nk = K >> 6;
  gemm_gload<AMODE>(ra0, rb0, A, lda, Bt, ldb, m0, n0, 0, pg);
  if (nk > 1) gemm_gload<AMODE>(ra1, rb1, A, lda, Bt, ldb, m0, n0, 64, pg);
  __syncthreads();
  gemm_lds_store(ra0, rb0, A0, B0, tid);
  __syncthreads();
  for (int k = 0; k < nk; k += 2) {
    if (k + 2 < nk) gemm_gload<AMODE>(ra0, rb0, A, lda, Bt, ldb, m0, n0, (k + 2) * 64, pg);
    gemm_compute(acc, A0, B0, wave, l15, quad);
    if (k + 1 < nk) gemm_lds_store(ra1, rb1, A1, B1, tid);
    __syncthreads();
    if (k + 1 < nk) {
      if (k + 3 < nk) gemm_gload<AMODE>(ra1, rb1, A, lda, Bt, ldb, m0, n0, (k + 3) * 64, pg);
      gemm_compute(acc, A1, B1, wave, l15, quad);
      if (k + 2 < nk) gemm_lds_store(ra0, rb0, A0, B0, tid);
      __syncthreads();
    }
  }
}


DEV void gemm_gload_big(u32x4 (&ra)[8], u32x4 (&rb)[4], const bf16_t* __restrict__ A, int lda, const bf16_t* __restrict__ Bt, int ldb,
                        int m0, int n0, int k0) {
  const int tid = TID();
#pragma unroll
  for (int i = 0; i < 8; i++) { const int c = tid + 256 * i, r = c >> 3, kc = (c & 7) * 8; ra[i] = *(const u32x4*)(A + (size_t)(m0 + r) * lda + k0 + kc); }
#pragma unroll
  for (int i = 0; i < 4; i++) { const int c = tid + 256 * i, r = c >> 3, kc = (c & 7) * 8; rb[i] = *(const u32x4*)(Bt + (size_t)(n0 + r) * ldb + k0 + kc); }
}
DEV void gemm_main_big(f32x4 (&acc)[4][8], const bf16_t* __restrict__ A, int lda, const bf16_t* __restrict__ Bt, int ldb,
                       int K, int m0, int n0, unsigned char* smem) {
  const int tid = TID(), lane = tid & 63, wave = tid >> 6, l15 = lane & 15, quad = lane >> 4;
  bf16_t* As = (bf16_t*)smem; bf16_t* Bs = As + 256 * 72;
#pragma unroll
  for (int i = 0; i < 4; i++)
#pragma unroll
    for (int j = 0; j < 8; j++) acc[i][j] = (f32x4){0.f, 0.f, 0.f, 0.f};
  u32x4 ra[8], rb[4];
  gemm_gload_big(ra, rb, A, lda, Bt, ldb, m0, n0, 0);
  for (int k0 = 0; k0 < K; k0 += 64) {
    __syncthreads();
#pragma unroll
    for (int i = 0; i < 8; i++) { const int c = tid + 256 * i, r = c >> 3, kc = (c & 7) * 8; *(u32x4*)(As + r * 72 + kc) = ra[i]; }
#pragma unroll
    for (int i = 0; i < 4; i++) { const int c = tid + 256 * i, r = c >> 3, kc = (c & 7) * 8; *(u32x4*)(Bs + r * 72 + kc) = rb[i]; }
    __syncthreads();
    if (k0 + 64 < K) gemm_gload_big(ra, rb, A, lda, Bt, ldb, m0, n0, k0 + 64);
#pragma unroll
    for (int ks = 0; ks < 2; ks++) {
      u32x4 af[4], bf[8];
#pragma unroll
      for (int mt = 0; mt < 4; mt++) af[mt] = *(const u32x4*)(As + (wave * 64 + mt * 16 + l15) * 72 + ks * 32 + quad * 8);
#pragma unroll
      for (int nt = 0; nt < 8; nt++) bf[nt] = *(const u32x4*)(Bs + (nt * 16 + l15) * 72 + ks * 32 + quad * 8);
      __builtin_amdgcn_sched_barrier(0);
#pragma unroll
      for (int nt = 0; nt < 8; nt++)
#pragma unroll
        for (int mt = 0; mt < 4; mt++) acc[mt][nt] = mfma16(bf[nt], af[mt], acc[mt][nt]);
      __builtin_amdgcn_sched_barrier(0);
    }
  }
}

DEV void rope4f(f32x4& X0, f32x4& X1, f32x4& X2, f32x4& X3, int pos, const float* ropeT, int quad) {
  const int rr = pos >> 6, cc = pos & 63;
  const f32x4 cr = *(const f32x4*)(ropeT + rr * 16 + quad * 4), sr = *(const f32x4*)(ropeT + 1024 + rr * 16 + quad * 4);
  const f32x4 c2 = *(const f32x4*)(ropeT + cc * 16 + quad * 4), s2 = *(const f32x4*)(ropeT + 1024 + cc * 16 + quad * 4);
#pragma unroll
  for (int j = 0; j < 4; j++) {
    float a0 = X0[j], a1 = X1[j]; X0[j] = a0 * cr[j] - a1 * sr[j]; X1[j] = a1 * cr[j] + a0 * sr[j];
    float b0 = X2[j], b1 = X3[j]; X2[j] = b0 * c2[j] - b1 * s2[j]; X3[j] = b1 * c2[j] + b0 * s2[j];
  }
}
#define ROPE4(X0, X1, X2, X3, pos_) rope4f(X0, X1, X2, X3, pos_, ropeT, quad);

enum { EPI_EVEN_IN = 0, EPI_ODD_IN, EPI_UQ, EPI_UK, EPI_UV, EPI_OUT, EPI_POOL, EPI_PQ };

template <int AMODE>
DEV void gemm_run(f32x4 (&acc)[2][8], const bf16_t* A, int lda, const bf16_t* Bt, int ldb, int K, int m0, int n0, unsigned char* smem, int pg) {
  gemm_main<AMODE>(acc, A, lda, Bt, ldb, K, m0, n0, smem, pg);
}
template <int AMODE>
DEV void gemm_run(f32x4 (&acc)[4][8], const bf16_t* A, int lda, const bf16_t* Bt, int ldb, int K, int m0, int n0, unsigned char* smem, int pg) {
  gemm_main_big(acc, A, lda, Bt, ldb, K, m0, n0, smem);
}

template <int EPI, int AMODE, int MT>
DEV void gemm_tile(const P& p, int l, const bf16_t* A, int lda, const bf16_t* Bt, int ldb, int K, int m0, int n0, unsigned char* smem, int pg) {
  f32x4 acc[MT][8];
  gemm_run<AMODE>(acc, A, lda, Bt, ldb, K, m0, n0, smem, pg);
  const int lane = TID() & 63, wave = TID() >> 6, l15 = lane & 15, quad = lane >> 4;
  unsigned char* ws = WS(p);
  const float* ropeT = (const float*)(ws + OFF_ROPE);
  const int e = l >> 1;
  if (EPI == EPI_EVEN_IN) {
    bf16_t* PROJ = (bf16_t*)(ws + OFF_PROJ); float* RAW = (float*)(ws + OFF_RAW);
#pragma unroll
    for (int mt = 0; mt < MT; mt++) {
      const int row = m0 + wave * (MT * 16) + mt * 16 + l15;
#pragma unroll
      for (int nt = 0; nt < 8; nt++) {
        const int col = n0 + nt * 16 + quad * 4;
        f32x4 v = acc[mt][nt];
        if (col < 1568) {
          if (col < 256) { v[0] *= 0.125f; v[1] *= 0.125f; v[2] *= 0.125f; v[3] *= 0.125f; }
          *(u32x2*)(PROJ + (size_t)row * 1568 + col) = pack4(v);
        } else if (col < 2144) {
          *(f32x4*)(RAW + (size_t)row * 576 + (col - 1568)) = v;
        }
      }
    }
  } else if (EPI == EPI_ODD_IN) {
    const int nb = n0 >> 7;
#pragma unroll
    for (int mt = 0; mt < MT; mt++) {
      const int row = m0 + wave * (MT * 16) + mt * 16 + l15;
      const bool samp = row >= TP;
      const int b = samp ? (row - TP) >> 12 : row >> 8;
      const int pos = samp ? (row - TP) & 4095 : row & 255;
      if (nb < 4) {
        bf16_t* XC = (bf16_t*)(ws + OFF_PROJ);
#pragma unroll
        for (int nt = 0; nt < 8; nt++) *(u32x2*)(XC + (size_t)row * 512 + n0 + nt * 16 + quad * 4) = pack4(acc[mt][nt]);
      } else if (nb < 9) {
        const float* g = (nb < 8 ? IN(p, I_GWQN) : IN(p, I_GWKN)) + e * 64;
#pragma unroll
        for (int hh = 0; hh < 2; hh++) {
          f32x4 x0 = acc[mt][hh * 4 + 0], x1 = acc[mt][hh * 4 + 1], x2 = acc[mt][hh * 4 + 2], x3 = acc[mt][hh * 4 + 3];
          float ss = 0;
#pragma unroll
          for (int j = 0; j < 4; j++) ss += x0[j] * x0[j] + x1[j] * x1[j] + x2[j] * x2[j] + x3[j] * x3[j];
          ss += __shfl_xor(ss, 16); ss += __shfl_xor(ss, 32);
          const float rstd = rsqrtf(ss * (1.f / 64.f) + EPS);
          const f32x4 g0 = *(const f32x4*)(g + quad * 4), g1 = *(const f32x4*)(g + 16 + quad * 4), g2 = *(const f32x4*)(g + 32 + quad * 4), g3 = *(const f32x4*)(g + 48 + quad * 4);
#pragma unroll
          for (int j = 0; j < 4; j++) { x0[j] *= rstd * g0[j]; x1[j] *= rstd * g1[j]; x2[j] *= rstd * g2[j]; x3[j] *= rstd * g3[j]; }
          if (nb < 8) {
            const int head = (nb - 4) * 2 + hh;
            if (samp) ROPE4(x0, x1, x2, x3, pos)
            bf16_t* q = (bf16_t*)(ws + OFF_QB) + (size_t)row * 512 + head * 64 + quad * 4;
            *(u32x2*)(q) = pack4(x0); *(u32x2*)(q + 16) = pack4(x1); *(u32x2*)(q + 32) = pack4(x2); *(u32x2*)(q + 48) = pack4(x3);
          } else {
            const int hk = hh;
            if (!samp) {
              float* o = OUT(p) + OUT_WIN + ((((size_t)(b * 2 + e) * 2 + 0) * 256 + pos) * 2 + hk) * 64 + quad * 4;
              *(f32x4*)(o) = x0; *(f32x4*)(o + 16) = x1; *(f32x4*)(o + 32) = x2; *(f32x4*)(o + 48) = x3;
              bf16_t* k = (bf16_t*)(ws + OFF_KP) + ((size_t)b * 256 + pos) * 128 + hk * 64 + quad * 4;
              *(u32x2*)(k) = pack4(x0); *(u32x2*)(k + 16) = pack4(x1); *(u32x2*)(k + 32) = pack4(x2); *(u32x2*)(k + 48) = pack4(x3);
            } else {
              ROPE4(x0, x1, x2, x3, pos)
              bf16_t* k = (bf16_t*)(ws + OFF_KS) + ((size_t)b * 4608 + pos) * 128 + hk * 64 + quad * 4;
              *(u32x2*)(k) = pack4(x0); *(u32x2*)(k + 16) = pack4(x1); *(u32x2*)(k + 32) = pack4(x2); *(u32x2*)(k + 48) = pack4(x3);
            }
          }
        }
      } else {
#pragma unroll
        for (int nt = 0; nt < 8; nt++) {
          const int hk = nt >> 2, d = (nt & 3) * 16 + quad * 4;
          const f32x4 v = acc[mt][nt];
          if (!samp) {
            *(f32x4*)(OUT(p) + OUT_WIN + ((((size_t)(b * 2 + e) * 2 + 1) * 256 + pos) * 2 + hk) * 64 + d) = v;
            bf16_t* vt = (bf16_t*)(ws + OFF_VTP) + ((size_t)(b * 2 + hk) * 64 + d) * 256 + pos;
#pragma unroll
            for (int j = 0; j < 4; j++) vt[(size_t)j * 256] = (bf16_t)f2bf_u(v[j]);
          } else {
            bf16_t* vt = (bf16_t*)(ws + OFF_VTS) + ((size_t)(b * 2 + hk) * 64 + d) * 4608 + pos;
#pragma unroll
            for (int j = 0; j < 4; j++) vt[(size_t)j * 4608] = (bf16_t)f2bf_u(v[j]);
          }
        }
      }
    }
  } else if (EPI == EPI_UQ) {
    const int head = n0 >> 7;
    const float* g = IN(p, I_GQN) + e * 128;
#pragma unroll
    for (int mt = 0; mt < MT; mt++) {
      const int row = m0 + wave * (MT * 16) + mt * 16 + l15;
      const bool samp = row >= TP;
      const int pos = (row - TP) & 4095;
      float ss = 0;
#pragma unroll
      for (int nt = 0; nt < 8; nt++)
#pragma unroll
        for (int j = 0; j < 4; j++) ss += acc[mt][nt][j] * acc[mt][nt][j];
      ss += __shfl_xor(ss, 16); ss += __shfl_xor(ss, 32);
      const float rstd = rsqrtf(ss * (1.f / 128.f) + EPS);
#pragma unroll
      for (int nt = 0; nt < 8; nt++) {
        const f32x4 gg = *(const f32x4*)(g + nt * 16 + quad * 4);
#pragma unroll
        for (int j = 0; j < 4; j++) acc[mt][nt][j] *= rstd * gg[j];
      }
      if (samp) ROPE4(acc[mt][4], acc[mt][5], acc[mt][6], acc[mt][7], pos)
      bf16_t* q = (bf16_t*)(ws + OFF_QB) + (size_t)row * 1024 + head * 128 + quad * 4;
#pragma unroll
      for (int nt = 0; nt < 8; nt++) *(u32x2*)(q + nt * 16) = pack4(acc[mt][nt]);
    }
  } else if (EPI == EPI_UK) {
    const int hp = n0 >> 7;
    const float* g = IN(p, I_GKN) + e * 128;
#pragma unroll
    for (int mt = 0; mt < MT; mt++) {
      const int row = m0 + wave * (MT * 16) + mt * 16 + l15;
      const float* krp; bf16_t* kdst; bool rope = false; int pos = 0;
      if (row < TP) { krp = (const float*)(ws + OFF_RAW) + (size_t)row * 576 + 512; kdst = (bf16_t*)(ws + OFF_KP) + (size_t)row * 1024; }
      else if (row < TT) { int b = (row - TP) >> 12; pos = (row - TP) & 4095; rope = true;
        krp = (const float*)(ws + OFF_RAW) + (size_t)row * 576 + 512; kdst = (bf16_t*)(ws + OFF_KS) + ((size_t)b * 4608 + pos) * 1024; }
      else { int r = row - TT, b = r >> 9, pp = r & 511;
        krp = IN(p, I_CKR) + ((size_t)(b * 2 + e) * 512 + pp) * 64; kdst = (bf16_t*)(ws + OFF_KS) + ((size_t)b * 4608 + 4096 + pp) * 1024; }
      f32x4 kr0 = *(const f32x4*)(krp + quad * 4), kr1 = *(const f32x4*)(krp + 16 + quad * 4), kr2 = *(const f32x4*)(krp + 32 + quad * 4), kr3 = *(const f32x4*)(krp + 48 + quad * 4);
      float krss = 0;
#pragma unroll
      for (int j = 0; j < 4; j++) krss += kr0[j] * kr0[j] + kr1[j] * kr1[j] + kr2[j] * kr2[j] + kr3[j] * kr3[j];
      const f32x4 gr0 = *(const f32x4*)(g + 64 + quad * 4), gr1 = *(const f32x4*)(g + 80 + quad * 4), gr2 = *(const f32x4*)(g + 96 + quad * 4), gr3 = *(const f32x4*)(g + 112 + quad * 4);
#pragma unroll
      for (int hh = 0; hh < 2; hh++) {
        float ss = krss;
#pragma unroll
        for (int u = 0; u < 4; u++)
#pragma unroll
          for (int j = 0; j < 4; j++) ss += acc[mt][hh * 4 + u][j] * acc[mt][hh * 4 + u][j];
        ss += __shfl_xor(ss, 16); ss += __shfl_xor(ss, 32);
        const float rstd = rsqrtf(ss * (1.f / 128.f) + EPS);
        bf16_t* kd = kdst + (hp * 2 + hh) * 128 + quad * 4;
#pragma unroll
        for (int u = 0; u < 4; u++) {
          const f32x4 gg = *(const f32x4*)(g + u * 16 + quad * 4);
          f32x4 v = acc[mt][hh * 4 + u];
#pragma unroll
          for (int j = 0; j < 4; j++) v[j] *= rstd * gg[j];
          *(u32x2*)(kd + u * 16) = pack4(v);
        }
        f32x4 x0, x1, x2, x3;
#pragma unroll
        for (int j = 0; j < 4; j++) { x0[j] = kr0[j] * rstd * gr0[j]; x1[j] = kr1[j] * rstd * gr1[j]; x2[j] = kr2[j] * rstd * gr2[j]; x3[j] = kr3[j] * rstd * gr3[j]; }
        if (rope) ROPE4(x0, x1, x2, x3, pos)
        *(u32x2*)(kd + 64) = pack4(x0); *(u32x2*)(kd + 80) = pack4(x1); *(u32x2*)(kd + 96) = pack4(x2); *(u32x2*)(kd + 112) = pack4(x3);
      }
    }
  } else if (EPI == EPI_UV) {
#pragma unroll
    for (int mt = 0; mt < MT; mt++) {
      const int row = m0 + wave * (MT * 16) + mt * 16 + l15;
      bf16_t* base; size_t ld;
      if (row < TP) { int b = row >> 8, pos = row & 255; base = (bf16_t*)(ws + OFF_VTP) + (size_t)b * 8 * 64 * 256 + pos; ld = 256; }
      else if (row < TT) { int b = (row - TP) >> 12, pos = (row - TP) & 4095; base = (bf16_t*)(ws + OFF_VTS) + (size_t)b * 8 * 64 * 4608 + pos; ld = 4608; }
      else { int r = row - TT, b = r >> 9, pp = r & 511; base = (bf16_t*)(ws + OFF_VTS) + (size_t)b * 8 * 64 * 4608 + 4096 + pp; ld = 4608; }
#pragma unroll
      for (int nt = 0; nt < 8; nt++) {
        const int hd = n0 + nt * 16 + quad * 4;
#pragma unroll
        for (int j = 0; j < 4; j++) base[(size_t)(hd + j) * ld] = (bf16_t)f2bf_u(acc[mt][nt][j]);
      }
    }
  } else if (EPI == EPI_OUT) {
    const float* mod = (const float*)(ws + OFF_MOD);
#pragma unroll
    for (int mt = 0; mt < MT; mt++) {
      const int row = m0 + wave * (MT * 16) + mt * 16 + l15;
      const float* gt = mod + (size_t)(l * 5 + cond_of(row)) * 6144 + 2048;
      float* xo = OUT(p) + (size_t)row * 1024;
      const float* xi = (l == 0) ? (row < TP ? IN(p, I_XP) + (size_t)row * 1024 : IN(p, I_XS) + (size_t)(row - TP) * 1024) : xo;
#pragma unroll
      for (int nt = 0; nt < 8; nt++) {
        const int col = n0 + nt * 16 + quad * 4;
        f32x4 xv = *(const f32x4*)(xi + col); const f32x4 gg = *(const f32x4*)(gt + col);
#pragma unroll
        for (int j = 0; j < 4; j++) xv[j] += gg[j] * acc[mt][nt][j];
        *(f32x4*)(xo + col) = xv;
      }
    }
  } else if (EPI == EPI_POOL) {
    const float* sc = IN(p, I_PSCALE) + e * 512 + pg * 128;
    bf16_t* MIX = (bf16_t*)(ws + OFF_MIX);
#pragma unroll
    for (int mt = 0; mt < MT; mt++) {
      const int row = m0 + wave * (MT * 16) + mt * 16 + l15;
#pragma unroll
      for (int nt = 0; nt < 8; nt++) {
        const int col = nt * 16 + quad * 4;
        const f32x4 s = *(const f32x4*)(sc + col); f32x4 v = acc[mt][nt];
#pragma unroll
        for (int j = 0; j < 4; j++) v[j] *= s[j];
        *(u32x2*)(MIX + (size_t)row * 1024 + pg * 128 + col) = pack4(v);
      }
    }
  } else if (EPI == EPI_PQ) {
    bf16_t* PQ = (bf16_t*)(ws + OFF_ODIR);
#pragma unroll
    for (int mt = 0; mt < MT; mt++) {
      const int row = m0 + wave * (MT * 16) + mt * 16 + l15;
#pragma unroll
      for (int nt = 0; nt < 8; nt++) *(u32x2*)(PQ + (size_t)row * 2048 + n0 + nt * 16 + quad * 4) = pack4(acc[mt][nt]);
    }
  }
}

DEV void phase_mla_prep(const P& p, int e) {
  const int lane = TID() & 63, wave = TID() >> 6;
  unsigned char* ws = WS(p);
  const float* RAW = (const float*)(ws + OFF_RAW);
  bf16_t* CQN = (bf16_t*)(ws + OFF_CQN); bf16_t* CKVN = (bf16_t*)(ws + OFF_CKVN);
  const f32x4 gq = *(const f32x4*)(IN(p, I_GCQ) + e * 256 + lane * 4), gk = *(const f32x4*)(IN(p, I_GCKV) + e * 256 + lane * 4);
  for (int tok = blockIdx.x * 4 + wave; tok < TT + 2048; tok += gridDim.x * 4) {
    if (tok < TT) {
      const float* r = RAW + (size_t)tok * 576;
      f32x4 cq = *(const f32x4*)(r + lane * 4), ck = *(const f32x4*)(r + 256 + lane * 4);
      float s1 = cq[0] * cq[0] + cq[1] * cq[1] + cq[2] * cq[2] + cq[3] * cq[3];
      float s2 = ck[0] * ck[0] + ck[1] * ck[1] + ck[2] * ck[2] + ck[3] * ck[3];
#pragma unroll
      for (int o = 32; o >= 1; o >>= 1) { s1 += __shfl_xor(s1, o); s2 += __shfl_xor(s2, o); }
      const float r1 = rsqrtf(s1 * (1.f / 256.f) + EPS), r2 = rsqrtf(s2 * (1.f / 256.f) + EPS);
#pragma unroll
      for (int j = 0; j < 4; j++) { cq[j] *= r1 * gq[j]; ck[j] *= r2 * gk[j]; }
      *(u32x2*)(CQN + (size_t)tok * 256 + lane * 4) = pack4(cq);
      *(u32x2*)(CKVN + (size_t)tok * 256 + lane * 4) = pack4(ck);
      if (tok < TP) {
        const int b = tok >> 8, pos = tok & 255;
        *(f32x4*)(OUT(p) + OUT_CKV + ((size_t)(b * 2 + e) * 256 + pos) * 256 + lane * 4) = ck;
        if (lane < 16) *(f32x4*)(OUT(p) + OUT_KR + ((size_t)(b * 2 + e) * 256 + pos) * 64 + lane * 4) = *(const f32x4*)(r + 512 + lane * 4);
      }
    } else {
      const int rr = tok - TT, b = rr >> 9, pp = rr & 511;
      const f32x4 v = *(const f32x4*)(IN(p, I_CCKV) + ((size_t)(b * 2 + e) * 512 + pp) * 256 + lane * 4);
      *(u32x2*)(CKVN + (size_t)tok * 256 + lane * 4) = pack4(v);
    }
  }
}


template <int DQ>
DEV void att_load(u32x4 (&kr)[DQ / 32], u32x4 (&vr)[2], const bf16_t* __restrict__ Kb, int k_ld, const bf16_t* __restrict__ Vt, int v_ld, int ks0) {
  constexpr int NKS = DQ / 32, CPR = DQ / 8;
  const int tid = TID();
#pragma unroll
  for (int i = 0; i < NKS; i++) { const int c = tid + 256 * i, r = c / CPR, kc = (c % CPR) * 8; kr[i] = *(const u32x4*)(Kb + (size_t)(ks0 + r) * k_ld + kc); }
#pragma unroll
  for (int i = 0; i < 2; i++) { const int c = tid + 256 * i, r = c >> 3, kc = (c & 7) * 8; vr[i] = *(const u32x4*)(Vt + (size_t)r * v_ld + ks0 + kc); }
}

template <int DQ, bool WIN>
DEV void attn_tile(const bf16_t* Kc, const bf16_t* Vc, const u32x4 (&qf)[2][DQ / 32], f32x4 (&oacc)[2][4], float (&m_run)[2], float (&l_run)[2],
                   float scale2, bool masked, int kstart, int qpos0, int wave, int l15, int quad) {
  constexpr int KLD = DQ + 8, NKS = DQ / 32;
  f32x4 s[2][4];
#pragma unroll
  for (int mt = 0; mt < 2; mt++)
#pragma unroll
    for (int kt = 0; kt < 4; kt++) s[mt][kt] = (f32x4){0.f, 0.f, 0.f, 0.f};
  {
    u32x4 kf[4][NKS];
#pragma unroll
    for (int kt = 0; kt < 4; kt++)
#pragma unroll
      for (int ks = 0; ks < NKS; ks++) kf[kt][ks] = *(const u32x4*)(Kc + (kt * 16 + l15) * KLD + ks * 32 + quad * 8);
#pragma unroll
    for (int kt = 0; kt < 4; kt++)
#pragma unroll
      for (int ks = 0; ks < NKS; ks++)
#pragma unroll
        for (int mt = 0; mt < 2; mt++) s[mt][kt] = mfma16(kf[kt][ks], qf[mt][ks], s[mt][kt]);
  }
#pragma unroll
  for (int mt = 0; mt < 2; mt++) {
    float mx = -1e30f;
    const int qpos = qpos0 + wave * 32 + mt * 16 + l15;
#pragma unroll
    for (int kt = 0; kt < 4; kt++)
#pragma unroll
      for (int j = 0; j < 4; j++) {
        float v = s[mt][kt][j] * scale2;
        if (WIN && masked) { int dlt = qpos - (kstart + kt * 16 + quad * 4 + j); dlt = dlt < 0 ? -dlt : dlt; if (dlt > 128) v = -1e30f; }
        s[mt][kt][j] = v; mx = fmaxf(mx, v);
      }
    mx = fmaxf(mx, __shfl_xor(mx, 16)); mx = fmaxf(mx, __shfl_xor(mx, 32));
    const float mnew = fmaxf(m_run[mt], mx);
    const bool grew = __builtin_amdgcn_ballot_w64(mnew > m_run[mt]) != 0ull;
    float psum = 0;
#pragma unroll
    for (int kt = 0; kt < 4; kt++)
#pragma unroll
      for (int j = 0; j < 4; j++) { float pv = __builtin_amdgcn_exp2f(s[mt][kt][j] - mnew); s[mt][kt][j] = pv; psum += pv; }
    if (grew) {
      const float alpha = __builtin_amdgcn_exp2f(m_run[mt] - mnew);
      m_run[mt] = mnew;
      l_run[mt] = l_run[mt] * alpha + psum;
#pragma unroll
      for (int vt = 0; vt < 4; vt++)
#pragma unroll
        for (int j = 0; j < 4; j++) oacc[mt][vt][j] *= alpha;
    } else l_run[mt] += psum;
  }
  {
    u32x4 vf[2][4];
#pragma unroll
    for (int u = 0; u < 2; u++)
#pragma unroll
      for (int vt = 0; vt < 4; vt++) {
        const u32x2 a = *(const u32x2*)(Vc + (vt * 16 + l15) * 72 + (2 * u) * 16 + quad * 4);
        const u32x2 b = *(const u32x2*)(Vc + (vt * 16 + l15) * 72 + (2 * u + 1) * 16 + quad * 4);
        vf[u][vt] = mk4(a.x, a.y, b.x, b.y);
      }
    u32x4 pf[2][2];
#pragma unroll
    for (int u = 0; u < 2; u++)
#pragma unroll
      for (int mt = 0; mt < 2; mt++) { u32x2 a = pack4(s[mt][2 * u]), b = pack4(s[mt][2 * u + 1]); pf[u][mt] = mk4(a.x, a.y, b.x, b.y); }
#pragma unroll
    for (int u = 0; u < 2; u++)
#pragma unroll
      for (int vt = 0; vt < 4; vt++)
#pragma unroll
        for (int mt = 0; mt < 2; mt++) oacc[mt][vt] = mfma16(vf[u][vt], pf[u][mt], oacc[mt][vt]);
  }
}

template <int DQ>
DEV void att_lds_store(const u32x4 (&kr)[DQ / 32], const u32x4 (&vr)[2], bf16_t* Kn, bf16_t* Vn, int tid) {
  constexpr int KLD = DQ + 8, NKS = DQ / 32, CPR = DQ / 8;
#pragma unroll
  for (int i = 0; i < NKS; i++) { const int c = tid + 256 * i, r = c / CPR, kc = (c % CPR) * 8; *(u32x4*)(Kn + r * KLD + kc) = kr[i]; }
#pragma unroll
  for (int i = 0; i < 2; i++) { const int c = tid + 256 * i, r = c >> 3, kc = (c & 7) * 8; *(u32x4*)(Vn + r * 72 + kc) = vr[i]; }
}

template <int DQ, bool WIN>
DEV void attn_item(const bf16_t* __restrict__ Q, int q_ld, const bf16_t* __restrict__ Kb, int k_ld, const bf16_t* __restrict__ Vt, int v_ld,
                   int r1_lo, int r1_hi, int r2_lo, int r2_hi, int qpos0, float scale, float sink, bool has_sink,
                   bf16_t* __restrict__ O, int o_ld, unsigned char* smem) {
  constexpr int KLD = DQ + 8, NKS = DQ / 32;
  const int tid = TID(), lane = tid & 63, wave = tid >> 6, l15 = lane & 15, quad = lane >> 4;
  constexpr int BUFE = 64 * KLD + 64 * 72;
  bf16_t* K0 = (bf16_t*)smem; bf16_t* V0 = K0 + 64 * KLD; bf16_t* K1 = K0 + BUFE; bf16_t* V1 = V0 + BUFE;
  u32x4 qf[2][NKS];
#pragma unroll
  for (int mt = 0; mt < 2; mt++)
#pragma unroll
    for (int ks = 0; ks < NKS; ks++) qf[mt][ks] = *(const u32x4*)(Q + (size_t)(wave * 32 + mt * 16 + l15) * q_ld + ks * 32 + quad * 8);
  float m_run[2], l_run[2]; f32x4 oacc[2][4];
#pragma unroll
  for (int mt = 0; mt < 2; mt++) {
    m_run[mt] = has_sink ? sink * 1.4426950408889634f : -1e30f; l_run[mt] = (has_sink && quad == 0) ? 1.f : 0.f;
#pragma unroll
    for (int vt = 0; vt < 4; vt++) oacc[mt][vt] = (f32x4){0.f, 0.f, 0.f, 0.f};
  }
  const int n1 = (r1_hi - r1_lo) >> 6, n2 = (r2_hi - r2_lo) >> 6, ntl = n1 + n2;
  const float scale2 = scale * 1.4426950408889634f;
#define KSTART(i_) ((i_) < n1 ? r1_lo + 64 * (i_) : r2_lo + 64 * ((i_) - n1))
  u32x4 kr0[NKS], vr0[2], kr1[NKS], vr1[2];
  att_load<DQ>(kr0, vr0, Kb, k_ld, Vt, v_ld, KSTART(0));
  if (ntl > 1) att_load<DQ>(kr1, vr1, Kb, k_ld, Vt, v_ld, KSTART(1));
  __syncthreads();
  att_lds_store<DQ>(kr0, vr0, K0, V0, tid);
  __syncthreads();
  for (int it = 0; it < ntl; it += 2) {
    if (it + 2 < ntl) att_load<DQ>(kr0, vr0, Kb, k_ld, Vt, v_ld, KSTART(it + 2));
    attn_tile<DQ, WIN>(K0, V0, qf, oacc, m_run, l_run, scale2, it < n1, KSTART(it), qpos0, wave, l15, quad);
    if (it + 1 < ntl) att_lds_store<DQ>(kr1, vr1, K1, V1, tid);
    __syncthreads();
    if (it + 1 < ntl) {
      if (it + 3 < ntl) att_load<DQ>(kr1, vr1, Kb, k_ld, Vt, v_ld, KSTART(it + 3));
      attn_tile<DQ, WIN>(K1, V1, qf, oacc, m_run, l_run, scale2, it + 1 < n1, KSTART(it + 1), qpos0, wave, l15, quad);
      if (it + 2 < ntl) att_lds_store<DQ>(kr0, vr0, K0, V0, tid);
      __syncthreads();
    }
  }
#undef KSTART
#pragma unroll
  for (int mt = 0; mt < 2; mt++) {
    float lt = l_run[mt]; lt += __shfl_xor(lt, 16); lt += __shfl_xor(lt, 32);
    const float inv = 1.f / lt;
    bf16_t* o = O + (size_t)(wave * 32 + mt * 16 + l15) * o_ld + quad * 4;
#pragma unroll
    for (int vt = 0; vt < 4; vt++) {
      f32x4 v = oacc[mt][vt];
#pragma unroll
      for (int j = 0; j < 4; j++) v[j] *= inv;
      *(u32x2*)(o + vt * 16) = pack4(v);
    }
  }
}

DEV void mla_attn_item(const P& p, int item, unsigned char* smem) {
  unsigned char* ws = WS(p);
  bf16_t* MIX = (bf16_t*)(ws + OFF_MIX);
  const float scale = 0.08838834764831845f;
  if (item < 1024) {
    const int qb = item & 31, h = (item >> 5) & 7, b = item >> 8;
    const int tok0 = TP + b * 4096 + qb * 128;
    attn_item<128, false>((const bf16_t*)(ws + OFF_QB) + (size_t)tok0 * 1024 + h * 128, 1024,
                          (const bf16_t*)(ws + OFF_KS) + (size_t)b * 4608 * 1024 + h * 128, 1024,
                          (const bf16_t*)(ws + OFF_VTS) + (size_t)(b * 8 + h) * 64 * 4608, 4608,
                          0, 4608, 0, 0, 0, scale, 0.f, false, MIX + (size_t)tok0 * 1024 + 512 + h * 64, 1024, smem);
  } else {
    const int it = item - 1024, qb = it & 1, h = (it >> 1) & 7, b = it >> 4;
    const int tok0 = b * 256 + qb * 128;
    attn_item<128, false>((const bf16_t*)(ws + OFF_QB) + (size_t)tok0 * 1024 + h * 128, 1024,
                          (const bf16_t*)(ws + OFF_KP) + (size_t)b * 256 * 1024 + h * 128, 1024,
                          (const bf16_t*)(ws + OFF_VTP) + (size_t)(b * 8 + h) * 64 * 256, 256,
                          0, 256, 0, 0, 0, scale, 0.f, false, MIX + (size_t)tok0 * 1024 + 512 + h * 64, 1024, smem);
  }
}

DEV void win_attn_item(const P& p, int o, int item, unsigned char* smem) {
  unsigned char* ws = WS(p);
  bf16_t* MIX = (bf16_t*)(ws + OFF_MIX);
  if (item < 1024) {
    const int qb = item & 31, h = (item >> 5) & 7, b = item >> 8, hk = h >> 2;
    const int tok0 = TP + b * 4096 + qb * 128;
    int lo = qb * 128 - 128, hi = qb * 128 + 256; lo = lo < 0 ? 0 : lo; hi = hi > 4096 ? 4096 : hi;
    attn_item<64, true>((const bf16_t*)(ws + OFF_QB) + (size_t)tok0 * 512 + h * 64, 512,
                        (const bf16_t*)(ws + OFF_KS) + (size_t)b * 4608 * 128 + hk * 64, 128,
                        (const bf16_t*)(ws + OFF_VTS) + (size_t)(b * 2 + hk) * 64 * 4608, 4608,
                        lo, hi, 4096, 4608, qb * 128, 0.125f, IN(p, I_SINK)[o * 8 + h], true, MIX + (size_t)tok0 * 1024 + 512 + h * 64, 1024, smem);
  } else {
    const int it = item - 1024, qb = it & 1, h = (it >> 1) & 7, b = it >> 4, hk = h >> 2;
    const int tok0 = b * 256 + qb * 128;
    attn_item<64, false>((const bf16_t*)(ws + OFF_QB) + (size_t)tok0 * 512 + h * 64, 512,
                         (const bf16_t*)(ws + OFF_KP) + (size_t)b * 256 * 128 + hk * 64, 128,
                         (const bf16_t*)(ws + OFF_VTP) + (size_t)(b * 2 + hk) * 64 * 256, 256,
                         0, 256, 0, 0, 0, 0.125f, IN(p, I_SINK)[o * 8 + h], true, MIX + (size_t)tok0 * 1024 + 512 + h * 64, 1024, smem);
  }
}

template <int dir>
DEV void gla_local_d(const P& p, int e, int cg, int h, unsigned char* smem) {
  const int tid = TID(), lane = tid & 63, wave = tid >> 6, l15 = lane & 15, quad = lane >> 4;
  unsigned char* ws = WS(p);
  bf16_t* QD = (bf16_t*)smem;
  bf16_t* KI = QD + 64 * 72;
  bf16_t* KST = KI + 64 * 72;
  bf16_t* VTs = KST + 64 * 72;
  float* DEC = (float*)(VTs + 128 * 72);
  float* WUP = DEC + 64;
  float* BUP = WUP + 1024;
  const int unit = (cg * 4 + h) * 2 + dir;
  const int tok0 = cg * 64;
  const bf16_t* row = (const bf16_t*)(ws + OFF_PROJ) + (size_t)(tok0 + lane) * 1568;
  u32x4 rl[2], rq[2], rk[2], rv[4];
  rl[0] = *(const u32x4*)(row + 1536 + dir * 16); rl[1] = *(const u32x4*)(row + 1536 + dir * 16 + 8);
  rq[0] = *(const u32x4*)(row + h * 64 + wave * 16); rq[1] = *(const u32x4*)(row + h * 64 + wave * 16 + 8);
  rk[0] = *(const u32x4*)(row + 256 + h * 64 + wave * 16); rk[1] = *(const u32x4*)(row + 256 + h * 64 + wave * 16 + 8);
#pragma unroll
  for (int i = 0; i < 4; i++) rv[i] = *(const u32x4*)(row + 512 + h * 128 + (wave + 4 * i) * 8);
  __syncthreads();
  for (int i = tid; i < 1024; i += 256) WUP[i] = IN(p, I_WGU)[((size_t)(e * 2 + dir) * 16 + (i >> 6)) * 256 + h * 64 + (i & 63)];
  if (tid < 64) BUP[tid] = IN(p, I_BGU)[(size_t)(e * 2 + dir) * 256 + h * 64 + tid];
  *(u32x4*)(QD + lane * 72 + wave * 16) = rq[0]; *(u32x4*)(QD + lane * 72 + wave * 16 + 8) = rq[1];
  *(u32x4*)(KI + lane * 72 + wave * 16) = rk[0]; *(u32x4*)(KI + lane * 72 + wave * 16 + 8) = rk[1];
#pragma unroll
  for (int i = 0; i < 4; i++) {
    bf16_t* d = VTs + ((wave + 4 * i) * 8) * 72 + lane;
    d[0 * 72] = (bf16_t)(rv[i].x & 0xffff); d[1 * 72] = (bf16_t)(rv[i].x >> 16);
    d[2 * 72] = (bf16_t)(rv[i].y & 0xffff); d[3 * 72] = (bf16_t)(rv[i].y >> 16);
    d[4 * 72] = (bf16_t)(rv[i].z & 0xffff); d[5 * 72] = (bf16_t)(rv[i].z >> 16);
    d[6 * 72] = (bf16_t)(rv[i].w & 0xffff); d[7 * 72] = (bf16_t)(rv[i].w >> 16);
  }
  __syncthreads();
  {
    float low[16];
    low[0] = lo2f(rl[0].x); low[1] = hi2f(rl[0].x); low[2] = lo2f(rl[0].y); low[3] = hi2f(rl[0].y);
    low[4] = lo2f(rl[0].z); low[5] = hi2f(rl[0].z); low[6] = lo2f(rl[0].w); low[7] = hi2f(rl[0].w);
    low[8] = lo2f(rl[1].x); low[9] = hi2f(rl[1].x); low[10] = lo2f(rl[1].y); low[11] = hi2f(rl[1].y);
    low[12] = lo2f(rl[1].z); low[13] = hi2f(rl[1].z); low[14] = lo2f(rl[1].w); low[15] = hi2f(rl[1].w);
#pragma unroll 4
    for (int dd = 0; dd < 16; dd++) {
      const int col = wave * 16 + dd;
      float zz = BUP[col];
#pragma unroll
      for (int r = 0; r < 16; r++) zz += low[r] * WUP[r * 64 + col];
      float v = (fminf(zz, 0.f) - __logf(1.f + __expf(-fabsf(zz)))) * (1.f / 16.f);
      if (dir == 0) {
#pragma unroll
        for (int off = 1; off < 64; off <<= 1) { float t2 = __shfl_up(v, off); if (lane >= off) v += t2; }
      } else {
#pragma unroll
        for (int off = 1; off < 64; off <<= 1) { float t2 = __shfl_down(v, off); if (lane + off < 64) v += t2; }
      }
      const float bl = __shfl(v, dir == 0 ? 63 : 0);
      const float qv = bf2f(QD[lane * 72 + col]), kv = bf2f(KI[lane * 72 + col]);
      QD[lane * 72 + col] = (bf16_t)f2bf_u(qv * __expf(v));
      KI[lane * 72 + col] = (bf16_t)f2bf_u(kv * __expf(-v));
      KST[col * 72 + lane] = (bf16_t)f2bf_u(kv * __expf(bl - v));
      if (lane == 0) DEC[col] = __expf(bl);
    }
  }
  __syncthreads();
  {
    u32x4 qdf[2];
#pragma unroll
    for (int ks = 0; ks < 2; ks++) qdf[ks] = *(const u32x4*)(QD + (wave * 16 + l15) * 72 + ks * 32 + quad * 8);
    f32x4 a[4];
    const int ii = wave * 16 + l15;
#pragma unroll
    for (int jt = 0; jt < 4; jt++) {
      a[jt] = (f32x4){0.f, 0.f, 0.f, 0.f};
#pragma unroll
      for (int ks = 0; ks < 2; ks++) a[jt] = mfma16(*(const u32x4*)(KI + (jt * 16 + l15) * 72 + ks * 32 + quad * 8), qdf[ks], a[jt]);
#pragma unroll
      for (int j = 0; j < 4; j++) { const int jj = jt * 16 + quad * 4 + j; const bool keep = dir == 0 ? (jj <= ii) : (jj >= ii); if (!keep) a[jt][j] = 0.f; }
    }
    u32x4 pf[2];
#pragma unroll
    for (int u = 0; u < 2; u++) { u32x2 x = pack4(a[2 * u]), y = pack4(a[2 * u + 1]); pf[u] = mk4(x.x, x.y, y.x, y.y); }
    float* orow = (float*)(ws + OFF_ODIR) + (size_t)dir * TT * 512 + (size_t)(tok0 + ii) * 512 + h * 128 + quad * 4;
#pragma unroll
    for (int vt = 0; vt < 8; vt++) {
      f32x4 o = (f32x4){0.f, 0.f, 0.f, 0.f};
#pragma unroll
      for (int u = 0; u < 2; u++) {
        const u32x2 x = *(const u32x2*)(VTs + (vt * 16 + l15) * 72 + (2 * u) * 16 + quad * 4);
        const u32x2 y = *(const u32x2*)(VTs + (vt * 16 + l15) * 72 + (2 * u + 1) * 16 + quad * 4);
        o = mfma16(mk4(x.x, x.y, y.x, y.y), pf[u], o);
      }
      *(f32x4*)(orow + vt * 16) = o;
    }
  }
  {
    bf16_t* qg = (bf16_t*)(ws + OFF_QDG) + (size_t)unit * 4096;
    bf16_t* kg = (bf16_t*)(ws + OFF_KSTG) + (size_t)unit * 4096;
#pragma unroll
    for (int i = 0; i < 2; i++) {
      const int c = tid + 256 * i, r = c >> 3, kc = (c & 7) * 8;
      *(u32x4*)(qg + r * 64 + kc) = *(const u32x4*)(QD + r * 72 + kc);
      *(u32x4*)(kg + r * 64 + kc) = *(const u32x4*)(KST + r * 72 + kc);
    }
    if (tid < 64) ((float*)(ws + OFF_DECG))[(size_t)unit * 64 + tid] = DEC[tid];
    if (dir == 0) {
      bf16_t* vg = (bf16_t*)(ws + OFF_VTG) + (size_t)(cg * 4 + h) * 8192;
#pragma unroll
      for (int i = 0; i < 4; i++) {
        const int c = tid + 256 * i, r = c >> 3, kc = (c & 7) * 8;
        *(u32x4*)(vg + r * 64 + kc) = *(const u32x4*)(VTs + r * 72 + kc);
      }
    }
  }
}
DEV void gla_local(const P& p, int e, int unit, unsigned char* smem) {
  const int cg = unit >> 3, h = (unit >> 1) & 3;
  if ((unit & 1) == 0) gla_local_d<0>(p, e, cg, h, smem); else gla_local_d<1>(p, e, cg, h, smem);
}

DEV void gla_seq(const P& p, int e, int item) {
  const int tid = TID(), lane = tid & 63, wave = tid >> 6, l15 = lane & 15, quad = lane >> 4;
  unsigned char* ws = WS(p);
  const bool samp = item < 32;
  const int it0 = samp ? item : item - 32;
  const int b = it0 >> 3, h = (it0 >> 1) & 3, dir = it0 & 1;
  const int nch = samp ? 64 : 4;
  const int tok_base = samp ? TP + b * 4096 : b * 256;
  const int cg0 = tok_base >> 6;
  f32x4 sacc[4][2];
#pragma unroll
  for (int dt = 0; dt < 4; dt++)
#pragma unroll
    for (int vt2 = 0; vt2 < 2; vt2++)
#pragma unroll
      for (int j = 0; j < 4; j++)
        sacc[dt][vt2][j] = samp ? IN(p, I_SGLA)[((((size_t)(b * 2 + e) * 2 + dir) * 4 + h) * 64 + dt * 16 + quad * 4 + j) * 128 + (2 * wave + vt2) * 16 + l15] : 0.f;
  float* oint = (float*)(ws + OFF_OINT) + (size_t)dir * TT * 512;
  unsigned pfacc = 0u;
#pragma unroll 2
  for (int ci = 0; ci < nch; ci++) {
    const int ch = dir == 0 ? ci : nch - 1 - ci;
    const int cg = cg0 + ch;
    const int unit = (cg * 4 + h) * 2 + dir;
    const bf16_t* qg = (const bf16_t*)(ws + OFF_QDG) + (size_t)unit * 4096;
    const bf16_t* kg = (const bf16_t*)(ws + OFF_KSTG) + (size_t)unit * 4096;
    const bf16_t* vg = (const bf16_t*)(ws + OFF_VTG) + (size_t)(cg * 4 + h) * 8192;
    const float* dg = (const float*)(ws + OFF_DECG) + (size_t)unit * 64;
    unsigned pv = 0u;
    if (ci + 1 < nch) {
      const int chn = dir == 0 ? ci + 1 : nch - 2 - ci;
      const int cgn = cg0 + chn, unitn = (cgn * 4 + h) * 2 + dir;
      const unsigned char* pf;
      if (lane < 16) pf = ws + OFF_QDG + (size_t)unitn * 8192 + (wave * 16 + lane) * 128;
      else if (lane < 32) pf = ws + OFF_KSTG + (size_t)unitn * 8192 + (wave * 16 + lane - 16) * 128;
      else pf = ws + OFF_VTG + (size_t)(cgn * 4 + h) * 16384 + (wave * 32 + lane - 32) * 128;
      if (wave == 0 && lane < 2) pf = ws + OFF_DECG + (size_t)unitn * 256 + lane * 128;
      pv = *(const volatile unsigned*)pf;
    }
    u32x2 qa[4][2][2];
#pragma unroll
    for (int it = 0; it < 4; it++)
#pragma unroll
      for (int u = 0; u < 2; u++) {
        qa[it][u][0] = *(const u32x2*)(qg + (it * 16 + l15) * 64 + (2 * u) * 16 + quad * 4);
        qa[it][u][1] = *(const u32x2*)(qg + (it * 16 + l15) * 64 + (2 * u + 1) * 16 + quad * 4);
      }
    u32x4 kf[4][2], vf[2][2]; f32x4 dc[4];
#pragma unroll
    for (int dt = 0; dt < 4; dt++) {
      dc[dt] = *(const f32x4*)(dg + dt * 16 + quad * 4);
#pragma unroll
      for (int ks = 0; ks < 2; ks++) kf[dt][ks] = *(const u32x4*)(kg + (dt * 16 + l15) * 64 + ks * 32 + quad * 8);
    }
#pragma unroll
    for (int vt2 = 0; vt2 < 2; vt2++)
#pragma unroll
      for (int ks = 0; ks < 2; ks++) vf[vt2][ks] = *(const u32x4*)(vg + ((2 * wave + vt2) * 16 + l15) * 64 + ks * 32 + quad * 8);
    u32x4 sb[2][2];
#pragma unroll
    for (int u = 0; u < 2; u++)
#pragma unroll
      for (int vt2 = 0; vt2 < 2; vt2++) { u32x2 x = pack4(sacc[2 * u][vt2]), y = pack4(sacc[2 * u + 1][vt2]); sb[u][vt2] = mk4(x.x, x.y, y.x, y.y); }
#pragma unroll
    for (int it = 0; it < 4; it++) {
#pragma unroll
      for (int vt2 = 0; vt2 < 2; vt2++) {
        f32x4 o = (f32x4){0.f, 0.f, 0.f, 0.f};
#pragma unroll
        for (int u = 0; u < 2; u++) o = mfma16(sb[u][vt2], mk4(qa[it][u][0].x, qa[it][u][0].y, qa[it][u][1].x, qa[it][u][1].y), o);
        *(f32x4*)(oint + (size_t)(tok_base + ch * 64 + it * 16 + l15) * 512 + h * 128 + (2 * wave + vt2) * 16 + quad * 4) = o;
      }
    }
#pragma unroll
    for (int dt = 0; dt < 4; dt++)
#pragma unroll
      for (int vt2 = 0; vt2 < 2; vt2++) {
        f32x4 sv = sacc[dt][vt2];
#pragma unroll
        for (int j = 0; j < 4; j++) sv[j] *= dc[dt][j];
#pragma unroll
        for (int ks = 0; ks < 2; ks++) sv = mfma16(kf[dt][ks], vf[vt2][ks], sv);
        sacc[dt][vt2] = sv;
      }
    pfacc += pv;
  }
  if (pfacc == 0xdeadbeefu) ((unsigned*)(ws + OFF_CTR))[63] = pfacc;
  if (!samp) {
#pragma unroll
    for (int dt = 0; dt < 4; dt++)
#pragma unroll
      for (int vt2 = 0; vt2 < 2; vt2++)
#pragma unroll
        for (int j = 0; j < 4; j++)
          OUT(p)[OUT_GLA + ((((size_t)(b * 2 + e) * 2 + dir) * 4 + h) * 64 + dt * 16 + quad * 4 + j) * 128 + (2 * wave + vt2) * 16 + l15] = sacc[dt][vt2][j];
  }
}

DEV void phase_gla_out(const P& p, int e) {
  const int lane = TID() & 63, wave = TID() >> 6;
  unsigned char* ws = WS(p);
  const float* O0 = (const float*)(ws + OFF_ODIR); const float* O1 = O0 + (size_t)TT * 512;
  const float* I0 = (const float*)(ws + OFF_OINT); const float* I1 = I0 + (size_t)TT * 512;
  const bf16_t* PROJ = (const bf16_t*)(ws + OFF_PROJ);
  bf16_t* MIX = (bf16_t*)(ws + OFF_MIX);
  const float* g = IN(p, I_GGO) + e * 128 + (lane & 15) * 8;
  const f32x4 g0 = *(const f32x4*)g, g1 = *(const f32x4*)(g + 4);
  for (int tok = blockIdx.x * 4 + wave; tok < TT; tok += gridDim.x * 4) {
    const size_t off = (size_t)tok * 512 + lane * 8;
    f32x4 a0 = *(const f32x4*)(O0 + off), a1 = *(const f32x4*)(O0 + off + 4);
    const f32x4 b0 = *(const f32x4*)(O1 + off), b1 = *(const f32x4*)(O1 + off + 4);
    const f32x4 c0 = *(const f32x4*)(I0 + off), c1 = *(const f32x4*)(I0 + off + 4);
    const f32x4 d0 = *(const f32x4*)(I1 + off), d1 = *(const f32x4*)(I1 + off + 4);
    float ss = 0;
#pragma unroll
    for (int j = 0; j < 4; j++) { a0[j] += b0[j] + c0[j] + d0[j]; a1[j] += b1[j] + c1[j] + d1[j]; ss += a0[j] * a0[j] + a1[j] * a1[j]; }
    ss += __shfl_xor(ss, 1); ss += __shfl_xor(ss, 2); ss += __shfl_xor(ss, 4); ss += __shfl_xor(ss, 8);
    const float rstd = rsqrtf(ss * (1.f / 128.f) + EPS);
    const u32x4 ru = *(const u32x4*)(PROJ + (size_t)tok * 1568 + 1024 + lane * 8);
    float ra[8] = {lo2f(ru.x), hi2f(ru.x), lo2f(ru.y), hi2f(ru.y), lo2f(ru.z), hi2f(ru.z), lo2f(ru.w), hi2f(ru.w)};
    float o[8];
#pragma unroll
    for (int j = 0; j < 4; j++) {
      o[j] = a0[j] * rstd * g0[j] * (ra[j] / (1.f + __expf(-ra[j])));
      o[4 + j] = a1[j] * rstd * g1[j] * (ra[4 + j] / (1.f + __expf(-ra[4 + j])));
    }
    u32x4 w; w.x = pack2(o[0], o[1]); w.y = pack2(o[2], o[3]); w.z = pack2(o[4], o[5]); w.w = pack2(o[6], o[7]);
    *(u32x4*)(MIX + (size_t)tok * 1024 + lane * 8) = w;
  }
}

DEV void topk_insert(float (&L)[16], float x) {
#pragma unroll
  for (int i = 15; i >= 1; i--) L[i] = __builtin_amdgcn_fmed3f(L[i - 1], L[i], x);
  L[0] = fmaxf(L[0], x);
}
#define TOPK_INSERT(L, x_) topk_insert(L, x_);

DEV void phase_peer_select(const P& p, int l, unsigned char* smem) {
  const int tid = TID(), lane = tid & 63, wave = tid >> 6, l15 = lane & 15, quad = lane >> 4;
  unsigned char* ws = WS(p);
  float* TOP = (float*)smem;
  float* SC = (float*)(smem + 32768) + wave * (64 * 33);
  const bf16_t* PQ = (const bf16_t*)(ws + OFF_ODIR);
  const bf16_t* SK = (const bf16_t*)(ws + OFF_SK) + (size_t)l * 8 * 2 * 128 * 128;
  int* SELI = (int*)(ws + OFF_SELI); float* SELG = (float*)(ws + OFF_SELG);
  for (int tile = blockIdx.x; tile < TT / 32; tile += gridDim.x) {
    const int tok0 = tile * 32;
    for (int hh = 0; hh < 2; hh++) {
      const int h = wave * 2 + hh;
      float L[16];
#pragma unroll
      for (int i = 0; i < 16; i++) L[i] = -3.0e38f;
      u32x4 qf[2][2][4];
#pragma unroll
      for (int c = 0; c < 2; c++)
#pragma unroll
        for (int mt = 0; mt < 2; mt++)
#pragma unroll
          for (int ks = 0; ks < 4; ks++)
            qf[c][mt][ks] = *(const u32x4*)(PQ + (size_t)(tok0 + mt * 16 + l15) * 2048 + h * 256 + c * 128 + ks * 32 + quad * 8);
      u32x4 sf[2][2][4];
#pragma unroll
      for (int c = 0; c < 2; c++)
#pragma unroll
        for (int kt = 0; kt < 2; kt++)
#pragma unroll
          for (int ks = 0; ks < 4; ks++)
            sf[c][kt][ks] = *(const u32x4*)(SK + ((size_t)(h * 2 + c) * 128 + kt * 16 + l15) * 128 + ks * 32 + quad * 8);
#pragma unroll 1
      for (int qt = 0; qt < 4; qt++) {
        asm volatile("s_waitcnt lgkmcnt(0)" ::: "memory");
#pragma unroll
        for (int c = 0; c < 2; c++)
#pragma unroll
          for (int mt = 0; mt < 2; mt++)
#pragma unroll
            for (int kt = 0; kt < 2; kt++) {
              f32x4 acc = (f32x4){0.f, 0.f, 0.f, 0.f};
#pragma unroll
              for (int ks = 0; ks < 4; ks++) acc = mfma16(sf[c][kt][ks], qf[c][mt][ks], acc);
              float* d = SC + ((mt * 16 + l15) * 2 + c) * 33 + kt * 16 + quad * 4;
              d[0] = acc[0]; d[1] = acc[1]; d[2] = acc[2]; d[3] = acc[3];
            }
        if (qt < 3) {
#pragma unroll
          for (int c = 0; c < 2; c++)
#pragma unroll
            for (int kt = 0; kt < 2; kt++)
#pragma unroll
              for (int ks = 0; ks < 4; ks++)
                sf[c][kt][ks] = *(const u32x4*)(SK + ((size_t)(h * 2 + c) * 128 + (qt + 1) * 32 + kt * 16 + l15) * 128 + ks * 32 + quad * 8);
        }
        asm volatile("s_waitcnt lgkmcnt(0)" ::: "memory");
#pragma unroll 4
        for (int k = 0; k < 32; k++) {
          const float x = __uint_as_float((__float_as_uint(SC[lane * 33 + k]) & ~127u) | (unsigned)(qt * 32 + k));
          TOPK_INSERT(L, x)
        }
      }
      float* td = TOP + (((lane >> 1) * 8 + h) * 2 + (lane & 1)) * 16;
#pragma unroll
      for (int i = 0; i < 16; i++) td[i] = L[i];
    }
    __syncthreads();
    {
      const int tk = tid >> 3, h = tid & 7;
      const float* ta = TOP + ((tk * 8 + h) * 2) * 16;
      float va[16], vb[16];
#pragma unroll
      for (int i = 0; i < 16; i++) { va[i] = __uint_as_float(__float_as_uint(ta[i]) & ~127u); vb[i] = __uint_as_float(__float_as_uint(ta[16 + i]) & ~127u); }
      float W[16];
#pragma unroll
      for (int i = 0; i < 16; i++) W[i] = -3.0e38f;
#pragma unroll
      for (int i = 0; i < 16; i++)
#pragma unroll
        for (int j = 0; j < 16 / (i + 1); j++) {
          const float s = va[i] + vb[j];
          const float x = __uint_as_float((__float_as_uint(s) & ~255u) | (unsigned)(i * 16 + j));
          TOPK_INSERT(W, x)
        }
      const float m = __uint_as_float(__float_as_uint(W[0]) & ~255u);
      float ex[16]; float Z = 0;
#pragma unroll
      for (int k = 0; k < 16; k++) { ex[k] = __expf(__uint_as_float(__float_as_uint(W[k]) & ~255u) - m); Z += ex[k]; }
      const float iz = 1.f / Z;
      int* si = SELI + (size_t)(tok0 + tk) * 128 + h * 16; float* sg = SELG + (size_t)(tok0 + tk) * 128 + h * 16;
#pragma unroll
      for (int k = 0; k < 16; k++) {
        const unsigned ij = __float_as_uint(W[k]) & 255u;
        const unsigned i1 = __float_as_uint(ta[ij >> 4]) & 127u, i2 = __float_as_uint(ta[16 + (ij & 15)]) & 127u;
        si[k] = (int)(i1 * 128 + i2); sg[k] = ex[k] * iz;
      }
    }
    __syncthreads();
  }
}

#define UNPACK8(dst, o, u) { dst[o+0] = lo2f(u.x); dst[o+1] = hi2f(u.x); dst[o+2] = lo2f(u.y); dst[o+3] = hi2f(u.y); dst[o+4] = lo2f(u.z); dst[o+5] = hi2f(u.z); dst[o+6] = lo2f(u.w); dst[o+7] = hi2f(u.w); }

typedef __attribute__((ext_vector_type(2))) float f32x2;
DEV void fp8x16_to_f32x2(f32x2 (&f)[8], u32x4 u) {
  const unsigned w[4] = {u.x, u.y, u.z, u.w};
#pragma unroll
  for (int i = 0; i < 4; i++) {
    f[i * 2 + 0] = __builtin_amdgcn_cvt_pk_f32_fp8((int)w[i], false);
    f[i * 2 + 1] = __builtin_amdgcn_cvt_pk_f32_fp8((int)w[i], true);
  }
}

DEV void phase_peer_gather(const P& p, int l, unsigned char* smem) {
  const int lane = TID() & 63, wave = TID() >> 6;
  unsigned char* ws = WS(p);
  const unsigned char* U = ws + OFF_U + (size_t)l * 16384 * 1024 + lane * 16;
  const unsigned char* Vb = ws + OFF_V + (size_t)l * 16384 * 1024;
  const float* USC = (const float*)(ws + OFF_USC) + l * 16384;
  const float* VSC = (const float*)(ws + OFF_VSC) + l * 16384;
  const bf16_t* H = (const bf16_t*)(ws + OFF_H);
  const int* SELI = (const int*)(ws + OFF_SELI); const float* SELG = (const float*)(ws + OFF_SELG);
  const float* mod = (const float*)(ws + OFF_MOD);
  u32x2* TAB = (u32x2*)smem + wave * (12 * 128);
  const int nw = gridDim.x * 4, gw = blockIdx.x * 4 + wave;
  for (int tbase = gw; tbase < TT; tbase += nw * 12) {
    {
      int* IDS = (int*)TAB;
      float* DOT = (float*)TAB + 12 * 128;
      const int l15 = lane & 15, quad = lane >> 4;
#pragma unroll 1
      for (int ti = 0; ti < 12; ti++) {
        const int tok = tbase + nw * ti;
        int i0 = 0, i1 = 0;
        if (tok < TT) { i0 = SELI[(size_t)tok * 128 + lane]; i1 = SELI[(size_t)tok * 128 + 64 + lane]; }
        IDS[ti * 128 + lane] = i0; IDS[ti * 128 + 64 + lane] = i1;
        DOT[ti * 128 + lane] = 0.f; DOT[ti * 128 + 64 + lane] = 0.f;
      }
      asm volatile("s_waitcnt lgkmcnt(0)" ::: "memory");
      const unsigned char* Ub = ws + OFF_U + (size_t)l * 16384 * 1024 + quad * 32;
#pragma unroll 1
      for (int c = 0; c < 8; c++) {
#pragma unroll 2
        for (int ti = 0; ti < 12; ti++) {
          const int tok = tbase + nw * ti;
          if (tok >= TT) continue;
          const unsigned char* h8 = ws + OFF_H8 + (size_t)tok * 1024 + c * 128 + quad * 32;
          const u32x4 xb0 = *(const u32x4*)h8, xb1 = *(const u32x4*)(h8 + 16);
          u32x4 ua[8][2];
#pragma unroll
          for (int g = 0; g < 8; g++) {
            const int eid = IDS[ti * 128 + g * 16 + l15];
            const unsigned char* ur = Ub + (size_t)eid * 1024 + c * 128;
            ua[g][0] = *(const u32x4*)ur; ua[g][1] = *(const u32x4*)(ur + 16);
          }
#pragma unroll
          for (int g = 0; g < 8; g++) {
            f32x4 acc = (f32x4){0.f, 0.f, 0.f, 0.f};
            acc = __builtin_amdgcn_mfma_f32_16x16x32_fp8_fp8((long)(((unsigned long long)ua[g][0].y << 32) | ua[g][0].x), (long)(((unsigned long long)xb0.y << 32) | xb0.x), acc, 0, 0, 0);
            acc = __builtin_amdgcn_mfma_f32_16x16x32_fp8_fp8((long)(((unsigned long long)ua[g][0].w << 32) | ua[g][0].z), (long)(((unsigned long long)xb0.w << 32) | xb0.z), acc, 0, 0, 0);
            acc = __builtin_amdgcn_mfma_f32_16x16x32_fp8_fp8((long)(((unsigned long long)ua[g][1].y << 32) | ua[g][1].x), (long)(((unsigned long long)xb1.y << 32) | xb1.x), acc, 0, 0, 0);
            acc = __builtin_amdgcn_mfma_f32_16x16x32_fp8_fp8((long)(((unsigned long long)ua[g][1].w << 32) | ua[g][1].z), (long)(((unsigned long long)xb1.w << 32) | xb1.z), acc, 0, 0, 0);
            if (l15 == 0) {
              float* d = DOT + ti * 128 + g * 16 + quad * 4;
              f32x4 cur = *(f32x4*)d;
              cur[0] += acc[0]; cur[1] += acc[1]; cur[2] += acc[2]; cur[3] += acc[3];
              *(f32x4*)d = cur;
            }
          }
        }
      }
      asm volatile("s_waitcnt lgkmcnt(0)" ::: "memory");
      int idl[12], idh[12]; float dl[12], dh[12];
#pragma unroll
      for (int ti = 0; ti < 12; ti++) { idl[ti] = IDS[ti * 128 + lane]; idh[ti] = IDS[ti * 128 + 64 + lane]; dl[ti] = DOT[ti * 128 + lane]; dh[ti] = DOT[ti * 128 + 64 + lane]; }
      asm volatile("s_waitcnt lgkmcnt(0)" ::: "memory");
#pragma unroll
      for (int ti = 0; ti < 12; ti++) {
        const int tok = tbase + nw * ti;
        u32x2 e0 = (u32x2){0u, 0u}, e1 = (u32x2){0u, 0u};
        if (tok < TT) {
          const float hs = ((const float*)(ws + OFF_HSC))[tok];
          const float g0 = SELG[(size_t)tok * 128 + lane], g1 = SELG[(size_t)tok * 128 + 64 + lane];
          const float d0 = dl[ti] * hs * USC[idl[ti]], d1 = dh[ti] * hs * USC[idh[ti]];
          const float a0 = 0.5f * d0 * (1.f + erff(d0 * 0.7071067811865475f)) * g0 * VSC[idl[ti]];
          const float a1 = 0.5f * d1 * (1.f + erff(d1 * 0.7071067811865475f)) * g1 * VSC[idh[ti]];
          e0 = (u32x2){(unsigned)idl[ti], __float_as_uint(a0)}; e1 = (u32x2){(unsigned)idh[ti], __float_as_uint(a1)};
        }
        TAB[ti * 128 + lane] = e0; TAB[ti * 128 + 64 + lane] = e1;
      }
    }
    asm volatile("s_waitcnt lgkmcnt(0)" ::: "memory");
    const int tq = lane >> 4, li = lane & 15;
#pragma unroll 1
    for (int c = 0; c < 8; c++) {
      const unsigned char* Vc = Vb + c * 128 + li * 8;
#pragma unroll 1
      for (int step = 0; step < 3; step++) {
        const int ti = step * 4 + tq;
        const int tok = tbase + nw * ti;
        const u32x2* tab = TAB + ti * 128;
        float acc[8];
#pragma unroll
        for (int i = 0; i < 8; i++) acc[i] = 0.f;
#pragma unroll 1
        for (int k = 0; k < 128; k += 32) {
          u32x2 rows[32]; float aw[32];
#pragma unroll
          for (int g = 0; g < 32; g++) { const u32x2 e = tab[k + g]; aw[g] = __uint_as_float(e.y); rows[g] = *(const u32x2*)(Vc + (size_t)e.x * 1024); }
#pragma unroll
          for (int g = 0; g < 32; g++) {
            const f32x2 f0 = __builtin_amdgcn_cvt_pk_f32_fp8((int)rows[g].x, false), f1 = __builtin_amdgcn_cvt_pk_f32_fp8((int)rows[g].x, true);
            const f32x2 f2 = __builtin_amdgcn_cvt_pk_f32_fp8((int)rows[g].y, false), f3 = __builtin_amdgcn_cvt_pk_f32_fp8((int)rows[g].y, true);
            acc[0] += aw[g] * f0[0]; acc[1] += aw[g] * f0[1]; acc[2] += aw[g] * f1[0]; acc[3] += aw[g] * f1[1];
            acc[4] += aw[g] * f2[0]; acc[5] += aw[g] * f2[1]; acc[6] += aw[g] * f3[0]; acc[7] += aw[g] * f3[1];
          }
        }
        if (tok < TT) {
          const float* gt = mod + (size_t)(l * 5 + cond_of(tok)) * 6144 + 5 * 1024 + c * 128 + li * 8;
          float* xo = OUT(p) + (size_t)tok * 1024 + c * 128 + li * 8;
#pragma unroll
          for (int q = 0; q < 2; q++) {
            f32x4 xv = *(f32x4*)(xo + q * 4); const f32x4 gg = *(const f32x4*)(gt + q * 4);
#pragma unroll
            for (int j = 0; j < 4; j++) xv[j] += gg[j] * acc[q * 4 + j];
            *(f32x4*)(xo + q * 4) = xv;
          }
        }
      }
    }
    if (l < 3) {
      asm volatile("s_waitcnt vmcnt(0)" ::: "memory");
#pragma unroll 1
      for (int ti = 0; ti < 12; ti++) {
        const int tok = tbase + nw * ti;
        if (tok >= TT) continue;
        const float* xo = OUT(p) + (size_t)tok * 1024 + lane * 16;
        f32x4 xn[4]; float ss = 0.f;
#pragma unroll
        for (int q = 0; q < 4; q++) { xn[q] = *(const f32x4*)(xo + q * 4); ss += xn[q][0] * xn[q][0] + xn[q][1] * xn[q][1] + xn[q][2] * xn[q][2] + xn[q][3] * xn[q][3]; }
#pragma unroll
        for (int o = 32; o >= 1; o >>= 1) ss += __shfl_xor(ss, o);
        const float rstd = rsqrtf(ss * (1.f / 1024.f) + EPS);
        const float* g1 = IN(p, I_GNORM) + (size_t)((l + 1) * 2) * 1024 + lane * 16;
        const float* mb = mod + (size_t)((l + 1) * 5 + cond_of(tok)) * 6144 + lane * 16;
        unsigned hw[8];
#pragma unroll
        for (int q = 0; q < 4; q++) {
          const f32x4 gg = *(const f32x4*)(g1 + q * 4), sh = *(const f32x4*)(mb + q * 4), sc = *(const f32x4*)(mb + 1024 + q * 4);
          f32x4 o;
#pragma unroll
          for (int j = 0; j < 4; j++) o[j] = xn[q][j] * rstd * gg[j] * (1.f + sc[j]) + sh[j];
          const u32x2 pk = pack4(o); hw[q * 2] = pk.x; hw[q * 2 + 1] = pk.y;
        }
        bf16_t* hd = (bf16_t*)(ws + OFF_H) + (size_t)tok * 1024 + lane * 16;
        *(u32x4*)hd = mk4(hw[0], hw[1], hw[2], hw[3]); *(u32x4*)(hd + 8) = mk4(hw[4], hw[5], hw[6], hw[7]);
      }
    }
    asm volatile("s_waitcnt lgkmcnt(0)" ::: "memory");
  }
}

DEV int next_item(unsigned* ctr, int* slot) {
  __syncthreads();
  if (TID() == 0) *slot = (int)atomicAdd(ctr, 1u);
  __syncthreads();
  return *slot;
}


#define XB_TMO      128
#define XB_XCNT(j)  (256  + 64 * (j))
#define XB_XSUB(j)  (1280 + 64 * (j))
#define XB_XGEN(j)  (2304 + 64 * (j))
#define XB_TOP      3328
#define XB_TOPGEN   3392
#define XCD_BAR_WORDS 3456
#define XB_SPIN_CAP (1u << 22)
#define LAS __attribute__((address_space(3)))
DEV unsigned xb_ld(unsigned* p)              { return __hip_atomic_load(p, __ATOMIC_RELAXED, __HIP_MEMORY_SCOPE_AGENT); }
DEV unsigned xb_add(unsigned* p, unsigned v) { return __hip_atomic_fetch_add(p, v, __ATOMIC_RELAXED, __HIP_MEMORY_SCOPE_AGENT); }
DEV unsigned xb_xcc_id() { return (unsigned)__builtin_amdgcn_s_getreg((3 << 11) | 20) & 0xFu; }
#define XB_SPIN(cond, bar) do { unsigned _sp = 0; while (cond) { __builtin_amdgcn_s_sleep(1); \
    if ((++_sp & 255u) == 0u) { if (xb_ld(&(bar)[XB_TMO])) break; if (_sp > XB_SPIN_CAP) { atomicAdd(&(bar)[XB_TMO], 1u); break; } } } } while (0)
struct XcdBarrier { unsigned* bar; unsigned x; volatile LAS unsigned* st; };
DEV XcdBarrier xcd_barrier_post(unsigned* bar, volatile LAS unsigned* st) {
  XcdBarrier b; b.bar = bar; b.x = xb_xcc_id(); b.st = st;
  if (threadIdx.x == 0) (void)xb_add(&bar[XB_XCNT(b.x)], 1u);
  return b;
}
DEV void xcd_barrier_complete(unsigned* bar, unsigned x, unsigned& nloc, unsigned& nx) {
  const unsigned G = gridDim.x * gridDim.y * gridDim.z;
  unsigned sum, cnt, mine, sp = 0u;
  for (;;) {
    sum = 0u; cnt = 0u; mine = 0u;
#pragma unroll
    for (unsigned j = 0; j < 16; ++j) { const unsigned c = xb_ld(&bar[XB_XCNT(j)]); sum += c; cnt += (c > 0u) ? 1u : 0u; mine = (j == x) ? c : mine; }
    if (sum == G) break;
    __builtin_amdgcn_s_sleep(1);
    if ((++sp & 255u) == 0u) { if (xb_ld(&bar[XB_TMO])) break; if (sp > XB_SPIN_CAP) { atomicAdd(&bar[XB_TMO], 1u); break; } }
  }
  nloc = mine > 0u ? mine : 1u; nx = cnt > 0u ? cnt : 1u;
}
DEV void xcd_barrier(const XcdBarrier& b) {
  asm volatile("s_waitcnt vmcnt(0)" ::: "memory");
  __syncthreads();
  if (threadIdx.x == 0) {
    unsigned* bar = b.bar;
    __builtin_amdgcn_s_waitcnt(0);
    unsigned nloc = b.st[0], nx = b.st[1];
    if (nloc == 0u) { xcd_barrier_complete(bar, b.x, nloc, nx); b.st[0] = nloc; b.st[1] = nx; }
    const unsigned old = xb_add(&bar[XB_XSUB(b.x)], 1u);
    const unsigned gen = old / nloc;
    if (old + 1u == (gen + 1u) * nloc) {
      __builtin_amdgcn_fence(__ATOMIC_RELEASE, "agent");
      asm volatile("s_waitcnt vmcnt(0)" ::: "memory");
      const unsigned og = xb_add(&bar[XB_TOP], 1u);
      const unsigned tg = og / nx;
      if (og + 1u == (tg + 1u) * nx) xb_add(&bar[XB_TOPGEN], 1u);
      else XB_SPIN(xb_ld(&bar[XB_TOPGEN]) == tg, bar);
      __builtin_amdgcn_fence(__ATOMIC_ACQUIRE, "agent");
      xb_add(&bar[XB_XGEN(b.x)], 1u);
      asm volatile("s_waitcnt vmcnt(0)" ::: "memory");
    } else {
      XB_SPIN(xb_ld(&bar[XB_XGEN(b.x)]) == gen, bar);
      __builtin_amdgcn_fence(__ATOMIC_ACQUIRE, "agent");
      asm volatile("s_waitcnt vmcnt(0)" ::: "memory");
    }
  }
  __syncthreads();
}

__global__ void __launch_bounds__(256, 2) mega(P p) {
  extern __shared__ __attribute__((aligned(16))) unsigned char smem[];
  cg::grid_group grid = cg::this_grid();
  unsigned char* ws = WS(p);
  unsigned* ctr = (unsigned*)(ws + OFF_CTR);
  int* slot = (int*)(smem + LDS_BYTES - 16);
  int ph = 0;
  volatile LAS unsigned* xst = (volatile LAS unsigned*)(smem + LDS_BYTES - 32);
  if (threadIdx.x == 0) { xst[0] = 0u; xst[1] = 0u; }
  __syncthreads();
  XcdBarrier xbar = xcd_barrier_post((unsigned*)(ws + OFF_BAR), xst);
#define RUN(...) do { if (ph >= p.ph_lo && ph < p.ph_hi) { __VA_ARGS__; if (ph + 1 < p.ph_hi) { if (ph == p.ph_lo) grid.sync(); else xcd_barrier(xbar); } } ++ph; } while (0)
#define RUNK(kind, ...) do { RUN(__VA_ARGS__); if (DUP_KIND == (kind)) RUN(__VA_ARGS__); } while (0)

  RUN({ phase_prologue(p, smem); });
#if DUP_KIND == 6
  RUN({ phase_prologue(p, smem); });
#endif

  for (int l = 0; l < 4; l++) {
    const int e = l >> 1;
    if ((l & 1) == 0) {
      if (l == 0) RUNK(7, { phase_norm(p, l, 0); });
      RUNK(2, { const int nbx = gridDim.x >> 3, nfull = (12 * 17 / nbx) * nbx;
            for (int t = blockIdx.x >> 3; t < nfull; t += nbx)
              gemm_tile<EPI_EVEN_IN, 0, 4>(p, l, (const bf16_t*)(ws + OFF_H), 1024, (const bf16_t*)(ws + OFF_WINE) + (size_t)e * 2176 * 1024, 1024, 1024, ((t / 17) * 8 + (blockIdx.x & 7)) * 256, (t % 17) * 128, smem, 0);
            for (int u = blockIdx.x >> 3; u < (12 * 17 - nfull) * 2; u += nbx) { const int t = nfull + (u >> 1);
              gemm_tile<EPI_EVEN_IN, 0, 2>(p, l, (const bf16_t*)(ws + OFF_H), 1024, (const bf16_t*)(ws + OFF_WINE) + (size_t)e * 2176 * 1024, 1024, 1024, ((t / 17) * 8 + (blockIdx.x & 7)) * 256 + (u & 1) * 128, (t % 17) * 128, smem, 0); } });
      RUNK(7, { phase_mla_prep(p, e); for (int u = blockIdx.x; u < 3072; u += gridDim.x) gla_local(p, e, u, smem); });
      RUNK(2, { const int xv = blockIdx.x & 7;
            for (int t = blockIdx.x >> 3; t < 96 + 52 + 52; t += gridDim.x >> 3) {
              if (t < 96) gemm_tile<EPI_UQ, 0, 4>(p, l, (const bf16_t*)(ws + OFF_CQN), 256, (const bf16_t*)(ws + OFF_WUQ) + (size_t)e * 1024 * 256, 256, 256, ((t >> 3) * 8 + xv) * 256, (t & 7) * 128, smem, 0);
              else if (t < 96 + 52) { int u = t - 96; gemm_tile<EPI_UK, 0, 4>(p, l, (const bf16_t*)(ws + OFF_CKVN), 256, (const bf16_t*)(ws + OFF_WUK) + (size_t)e * 512 * 256, 256, 256, ((u >> 2) * 8 + xv) * 256, (u & 3) * 128, smem, 0); }
              else { int u = t - 96 - 52; gemm_tile<EPI_UV, 0, 4>(p, l, (const bf16_t*)(ws + OFF_CKVN), 256, (const bf16_t*)(ws + OFF_WUV) + (size_t)e * 512 * 256, 256, 256, ((u >> 2) * 8 + xv) * 256, (u & 3) * 128, smem, 0); }
            } });
      RUNK(3, {
            for (int it = next_item(ctr + ph, slot); it < 1824; it = next_item(ctr + ph, slot)) {
              if (it < 32) gla_seq(p, e, it);
              else if (it < 1056) mla_attn_item(p, it - 32, smem);
              else if (it < 1312) gla_seq(p, e, it - 1056 + 32);
              else mla_attn_item(p, it - 1312 + 1024, smem);
            } });
      RUNK(7, { phase_gla_out(p, e); });
      RUN({ const int nbx = gridDim.x >> 3, nfull = (12 * 8 / nbx) * nbx;
            for (int t = blockIdx.x >> 3; t < nfull; t += nbx)
              gemm_tile<EPI_OUT, 0, 4>(p, l, (const bf16_t*)(ws + OFF_MIX), 1024, (const bf16_t*)(ws + OFF_WOE) + (size_t)e * 1024 * 1024, 1024, 1024, ((t >> 3) * 8 + (blockIdx.x & 7)) * 256, (t & 7) * 128, smem, 0);
            for (int u = blockIdx.x >> 3; u < (12 * 8 - nfull) * 2; u += nbx) { const int t = nfull + (u >> 1);
              gemm_tile<EPI_OUT, 0, 2>(p, l, (const bf16_t*)(ws + OFF_MIX), 1024, (const bf16_t*)(ws + OFF_WOE) + (size_t)e * 1024 * 1024, 1024, 1024, ((t >> 3) * 8 + (blockIdx.x & 7)) * 256 + (u & 1) * 128, (t & 7) * 128, smem, 0); } });
    } else {
      RUNK(2, { phase_winctx(p, e); for (int t = blockIdx.x >> 3; t < 12 * 10; t += gridDim.x >> 3)
              gemm_tile<EPI_ODD_IN, 0, 4>(p, l, (const bf16_t*)(ws + OFF_H), 1024, (const bf16_t*)(ws + OFF_WINO) + (size_t)e * 1280 * 1024, 1024, 1024, ((t / 10) * 8 + (blockIdx.x & 7)) * 256, (t % 10) * 128, smem, 0); });
      RUNK(4, {
            for (int it = next_item(ctr + ph, slot); it < 2304; it = next_item(ctr + ph, slot)) {
              if (it < 1024) win_attn_item(p, e, it, smem);
              else if (it < 1792) { int u = it - 1024; int g = u & 3;
                gemm_tile<EPI_POOL, 1, 2>(p, l, (const bf16_t*)(ws + OFF_PROJ), 512, (const bf16_t*)(ws + OFF_WPOOL) + (size_t)(e * 4 + g) * 16384, 128, 128, (u >> 2) * 128, 0, smem, g); }
              else win_attn_item(p, e, it - 1792 + 1024, smem);
            } });
      RUN({ const int nbx = gridDim.x >> 3, nfull = (12 * 8 / nbx) * nbx;
            for (int t = blockIdx.x >> 3; t < nfull; t += nbx)
              gemm_tile<EPI_OUT, 0, 4>(p, l, (const bf16_t*)(ws + OFF_MIX), 1024, (const bf16_t*)(ws + OFF_WOO) + (size_t)e * 1024 * 1024, 1024, 1024, ((t >> 3) * 8 + (blockIdx.x & 7)) * 256, (t & 7) * 128, smem, 0);
            for (int u = blockIdx.x >> 3; u < (12 * 8 - nfull) * 2; u += nbx) { const int t = nfull + (u >> 1);
              gemm_tile<EPI_OUT, 0, 2>(p, l, (const bf16_t*)(ws + OFF_MIX), 1024, (const bf16_t*)(ws + OFF_WOO) + (size_t)e * 1024 * 1024, 1024, 1024, ((t >> 3) * 8 + (blockIdx.x & 7)) * 256 + (u & 1) * 128, (t & 7) * 128, smem, 0); } });
    }
    RUNK(7, { phase_norm(p, l, 1); });
    RUNK(2, { for (int t = blockIdx.x >> 3; t < 12 * 16; t += gridDim.x >> 3)
            gemm_tile<EPI_PQ, 0, 4>(p, l, (const bf16_t*)(ws + OFF_H), 1024, (const bf16_t*)(ws + OFF_WQ) + (size_t)l * 2048 * 1024, 1024, 1024, ((t >> 4) * 8 + (blockIdx.x & 7)) * 256, (t & 15) * 128, smem, 0); });
    RUNK(5, { phase_peer_select(p, l, smem); });
    RUN({ phase_peer_gather(p, l, smem); });
  }
#undef RUN
#undef RUNK
}

extern "C" void kernel_launch(void* const* d_in, const int* in_sizes, int n_in, void* d_out, int out_size, void* d_ws, size_t ws_size, hipStream_t stream) {
  static int grid_blocks = 0;
  if (grid_blocks == 0) {
    if (ws_size < WS_END) { fprintf(stderr, "kernel_launch: workspace too small: %zu < %zu\n", ws_size, (size_t)WS_END); grid_blocks = -1; return; }
    int dev = 0, cus = 0, per_cu = 0;
    hipGetDevice(&dev);
    hipDeviceGetAttribute(&cus, hipDeviceAttributeMultiprocessorCount, dev);
    hipFuncSetAttribute((const void*)mega, hipFuncAttributeMaxDynamicSharedMemorySize, LDS_BYTES);
    hipOccupancyMaxActiveBlocksPerMultiprocessor(&per_cu, (const void*)mega, 256, LDS_BYTES);
    if (per_cu < 1) per_cu = 1;
    if (per_cu > 2) per_cu = 2;
    grid_blocks = cus * per_cu;
    grid_blocks -= grid_blocks % 8;
  }
  if (grid_blocks < 0) return;
  (void)hipMemsetAsync((char*)d_ws + OFF_CTR, 0, 256 + XCD_BAR_WORDS * 4, stream);
  P p{};
  for (int i = 0; i < 34; i++) p.in[i] = (const float*)d_in[i];
  p.out = (float*)d_out; p.ws = (unsigned char*)d_ws;
#if N_LAUNCH_PER_PHASE
  for (int ph = 0; ph < NPHASES; ph++) {
    p.ph_lo = ph; p.ph_hi = ph + 1;
    hipLaunchKernelGGL(mega, dim3(grid_blocks), dim3(256), LDS_BYTES, stream, p);
  }
#else
  p.ph_lo = 0; p.ph_hi = NPHASES + (DUP_KIND ? 64 : 0);
  void* args[] = {&p};
  hipError_t e = hipLaunchCooperativeKernel((const void*)mega, dim3(grid_blocks), dim3(256), args, LDS_BYTES, stream);
  if (e != hipSuccess) fprintf(stderr, "cooperative launch failed: %s (grid %d)\n", hipGetErrorString(e), grid_blocks);
#endif
}
```

```cpp
#include <hip/hip_runtime.h>
#include <hip/hip_cooperative_groups.h>
#include <cstdio>
#include <cstdint>
namespace cg = cooperative_groups;

#ifndef DUP_KIND
#define DUP_KIND 0
#endif
#ifndef N_LAUNCH_PER_PHASE
#define N_LAUNCH_PER_PHASE 0
#endif

#define DEV __device__ __forceinline__
typedef unsigned short bf16_t;
typedef __attribute__((ext_vector_type(4))) float f32x4;
typedef __attribute__((ext_vector_type(8))) __bf16 bf16x8;
typedef __attribute__((ext_vector_type(4))) unsigned u32x4;
typedef __attribute__((ext_vector_type(2))) unsigned u32x2;
DEV u32x4 mk4(unsigned a, unsigned b, unsigned c, unsigned d) { u32x4 r; r.x = a; r.y = b; r.z = c; r.w = d; return r; }

DEV float bf2f(bf16_t v) { return __uint_as_float(((unsigned)v) << 16); }
typedef __attribute__((ext_vector_type(2))) __bf16 bf16x2_t;
DEV unsigned pack2(float a, float b) { bf16x2_t v = {(__bf16)a, (__bf16)b}; return __builtin_bit_cast(unsigned, v); }
DEV unsigned f2bf_u(float f) { return pack2(f, 0.f) & 0xffffu; }
DEV float lo2f(unsigned w) { return __uint_as_float(w << 16); }
DEV float hi2f(unsigned w) { return __uint_as_float(w & 0xffff0000u); }
DEV f32x4 mfma16(u32x4 a, u32x4 b, f32x4 c) {
  return __builtin_amdgcn_mfma_f32_16x16x32_bf16(__builtin_bit_cast(bf16x8, a), __builtin_bit_cast(bf16x8, b), c, 0, 0, 0);
}
DEV u32x2 pack4(f32x4 v) { u32x2 r; r.x = pack2(v[0], v[1]); r.y = pack2(v[2], v[3]); return r; }

constexpr int TP = 8192, TT = 24576;
constexpr float EPS = 1e-6f;
constexpr size_t OUT_GLA = 25165824, OUT_CKV = 29360128, OUT_KR = 33554432, OUT_WIN = 34603008;

constexpr size_t AL(size_t x) { return (x + 255) & ~size_t(255); }
constexpr size_t OFF_CTR  = 0;
constexpr size_t OFF_BAR  = 256;
constexpr size_t OFF_MOD  = 256 + 3456 * 4;
constexpr size_t OFF_ROPE = OFF_MOD + AL(4 * 5 * 6144 * 4);
constexpr size_t OFF_WINE = OFF_ROPE + AL(2 * 1024 * 4);
constexpr size_t OFF_WUQ  = OFF_WINE + AL((size_t)2 * 2176 * 1024 * 2);
constexpr size_t OFF_WUK  = OFF_WUQ + AL((size_t)2 * 1024 * 256 * 2);
constexpr size_t OFF_WUV  = OFF_WUK + AL((size_t)2 * 512 * 256 * 2);
constexpr size_t OFF_WOE  = OFF_WUV + AL((size_t)2 * 512 * 256 * 2);
constexpr size_t OFF_WINO = OFF_WOE + AL((size_t)2 * 1024 * 1024 * 2);
constexpr size_t OFF_WPOOL= OFF_WINO + AL((size_t)2 * 1280 * 1024 * 2);
constexpr size_t OFF_WOO  = OFF_WPOOL + AL((size_t)8 * 128 * 128 * 2);
constexpr size_t OFF_WQ   = OFF_WOO + AL((size_t)2 * 1024 * 1024 * 2);
constexpr size_t OFF_SK   = OFF_WQ + AL((size_t)4 * 2048 * 1024 * 2);
constexpr size_t OFF_U    = OFF_SK + AL((size_t)4 * 8 * 2 * 128 * 128 * 2);
constexpr size_t OFF_V    = OFF_U + AL((size_t)4 * 16384 * 1024);
constexpr size_t OFF_USC  = OFF_V + AL((size_t)4 * 16384 * 1024);
constexpr size_t OFF_VSC  = OFF_USC + AL((size_t)4 * 16384 * 4);
constexpr size_t OFF_H    = OFF_VSC + AL((size_t)4 * 16384 * 4);
constexpr size_t OFF_PROJ = OFF_H + AL((size_t)TT * 1024 * 2);
constexpr size_t OFF_RAW  = OFF_PROJ + AL((size_t)TT * 1568 * 2);
constexpr size_t OFF_CQN  = OFF_RAW + AL((size_t)TT * 576 * 4);
constexpr size_t OFF_CKVN = OFF_CQN + AL((size_t)TT * 256 * 2);
constexpr size_t OFF_QB   = OFF_CKVN + AL((size_t)(TT + 2048) * 256 * 2);
constexpr size_t OFF_KS   = OFF_QB + AL((size_t)TT * 1024 * 2);
constexpr size_t OFF_KP   = OFF_KS + AL((size_t)4 * 4608 * 1024 * 2);
constexpr size_t OFF_VTS  = OFF_KP + AL((size_t)32 * 256 * 1024 * 2);
constexpr size_t OFF_VTP  = OFF_VTS + AL((size_t)4 * 8 * 64 * 4608 * 2);
constexpr size_t OFF_ODIR = OFF_VTP + AL((size_t)32 * 8 * 64 * 256 * 2);
constexpr size_t OFF_MIX  = OFF_ODIR + AL((size_t)2 * TT * 512 * 4);
constexpr size_t OFF_SELI = OFF_MIX + AL((size_t)TT * 1024 * 2);
constexpr size_t OFF_SELG = OFF_SELI + AL((size_t)TT * 128 * 4);
constexpr size_t OFF_QDG  = OFF_SELG + AL((size_t)TT * 128 * 4);
constexpr size_t OFF_KSTG = OFF_QDG + AL((size_t)3072 * 4096 * 2);
constexpr size_t OFF_DECG = OFF_KSTG + AL((size_t)3072 * 4096 * 2);
constexpr size_t OFF_VTG  = OFF_DECG + AL((size_t)3072 * 64 * 4);
constexpr size_t OFF_OINT = OFF_VTG + AL((size_t)1536 * 8192 * 2);
constexpr size_t OFF_H8   = OFF_OINT + AL((size_t)2 * TT * 512 * 4);
constexpr size_t OFF_HSC  = OFF_H8 + AL((size_t)TT * 1024);
constexpr size_t WS_END   = OFF_HSC + AL((size_t)TT * 4);

constexpr int LDS_BYTES = 75776;
constexpr int NPHASES = 36;

struct P { const float* in[34]; float* out; unsigned char* ws; int ph_lo, ph_hi; };
DEV int TID() { int t = (int)__builtin_amdgcn_workitem_id_x(); asm volatile("" : "+v"(t)); return t; }
#define GAS __attribute__((address_space(1)))
DEV unsigned char* WS(const P& p) { size_t z = 0; asm volatile("" : "+s"(z)); return p.ws + z; }
DEV const float* IN(const P& p, int i) { return (const float*)(GAS const float*)p.in[i]; }
DEV float* OUT(const P& p) { return (float*)(GAS float*)p.out; }

enum { I_XP = 0, I_XS, I_SGLA, I_CCKV, I_CKR, I_CWIN, I_C, I_CCTX, I_GNORM, I_WADA, I_BADA, I_WINE, I_WGU, I_BGU, I_GGO, I_GCQ, I_GCKV,
       I_WUQ, I_WUK, I_WUV, I_GQN, I_GKN, I_WOE, I_WINO, I_WPOOL, I_PSCALE, I_GWQN, I_GWKN, I_SINK, I_WOO, I_PWQ, I_PSK, I_PU, I_PV };

DEV int cond_of(int tok) { return tok < TP ? 0 : 1 + ((tok - TP) >> 12); }

DEV void transpose_cvt(const float* __restrict__ src, bf16_t* __restrict__ dst, int K, int N, unsigned char* smem) {
  float (*t)[33] = (float (*)[33])smem;
  const int tid = TID();
  const int nN = N >> 5, ntile = (K >> 6) * nN;
  for (int tile = blockIdx.x; tile < ntile; tile += gridDim.x) {
    const int k0 = (tile / nN) << 6, n0 = (tile % nN) << 5;
    __syncthreads();
#pragma unroll
    for (int i = 0; i < 2; i++) {
      int k = (tid >> 3) + 32 * i, n4 = (tid & 7) * 4;
      float4 v = *(const float4*)(src + (size_t)(k0 + k) * N + n0 + n4);
      t[k][n4] = v.x; t[k][n4 + 1] = v.y; t[k][n4 + 2] = v.z; t[k][n4 + 3] = v.w;
    }
    __syncthreads();
    int n = tid >> 3, k8 = (tid & 7) * 8;
    u32x4 o;
    o.x = pack2(t[k8][n], t[k8 + 1][n]); o.y = pack2(t[k8 + 2][n], t[k8 + 3][n]);
    o.z = pack2(t[k8 + 4][n], t[k8 + 5][n]); o.w = pack2(t[k8 + 6][n], t[k8 + 7][n]);
    *(u32x4*)(dst + (size_t)(n0 + n) * K + k0 + k8) = o;
  }
}

DEV void cvt_bf16(const float* __restrict__ src, bf16_t* __restrict__ dst, size_t n8) {
  for (size_t i = (size_t)blockIdx.x * 256 + TID(); i < n8; i += (size_t)gridDim.x * 256) {
    float4 a = *(const float4*)(src + i * 8), b = *(const float4*)(src + i * 8 + 4);
    u32x4 o; o.x = pack2(a.x, a.y); o.y = pack2(a.z, a.w); o.z = pack2(b.x, b.y); o.w = pack2(b.z, b.w);
    *(u32x4*)(dst + i * 8) = o;
  }
}

DEV void cvt_fp8_rows(const float* __restrict__ src, unsigned char* __restrict__ dst, float* __restrict__ scales, int nrows) {
  const int lane = TID() & 63, wave = TID() >> 6;
  for (int row = blockIdx.x * 4 + wave; row < nrows; row += gridDim.x * 4) {
    const float* r = src + (size_t)row * 1024 + lane * 16;
    f32x4 v[4];
    float am = 0.f;
#pragma unroll
    for (int i = 0; i < 4; i++) { v[i] = *(const f32x4*)(r + i * 4);
#pragma unroll
      for (int j = 0; j < 4; j++) am = fmaxf(am, fabsf(v[i][j])); }
#pragma unroll
    for (int o = 32; o >= 1; o >>= 1) am = fmaxf(am, __shfl_xor(am, o));
    const float sc = am > 0.f ? 440.f / am : 1.f;
    u32x4 o;
    unsigned w[4];
#pragma unroll
    for (int i = 0; i < 4; i++) {
      int t = 0;
      t = __builtin_amdgcn_cvt_pk_fp8_f32(v[i][0] * sc, v[i][1] * sc, t, false);
      t = __builtin_amdgcn_cvt_pk_fp8_f32(v[i][2] * sc, v[i][3] * sc, t, true);
      w[i] = (unsigned)t;
    }
    o.x = w[0]; o.y = w[1]; o.z = w[2]; o.w = w[3];
    *(u32x4*)(dst + (size_t)row * 1024 + lane * 16) = o;
    if (lane == 0) scales[row] = am > 0.f ? am / 440.f : 1.f;
  }
}

DEV void phase_prologue(const P& p, unsigned char* smem) {
  const int tid = TID();
  unsigned char* ws = WS(p);
  if (blockIdx.x == 0) {
    float* rt = (float*)(ws + OFF_ROPE);
    for (int i = tid; i < 1024; i += 256) {
      int pos = i >> 4, f = i & 15;
      float inv = powf(10000.f, -(float)f / 16.f);
      float ang = (float)pos * inv;
      rt[i] = cosf(ang); rt[1024 + i] = sinf(ang);
    }
  }
  {
    float* red = (float*)smem;
    float* mod = (float*)(ws + OFF_MOD);
    const int col = tid & 63, kq = tid >> 6;
    for (int tile = blockIdx.x; tile < 4 * 96; tile += gridDim.x) {
      const int l = tile / 96, c0 = (tile % 96) * 64;
      const float* w = IN(p, I_WADA) + (size_t)l * 1024 * 6144 + c0 + col;
      float a0 = 0, a1 = 0, a2 = 0, a3 = 0, a4 = 0;
#pragma unroll 8
      for (int k = kq * 256; k < kq * 256 + 256; k++) {
        float wv = w[(size_t)k * 6144];
        float c0v = IN(p, I_CCTX)[k], c1 = IN(p, I_C)[k], c2 = IN(p, I_C)[1024 + k], c3 = IN(p, I_C)[2048 + k], c4 = IN(p, I_C)[3072 + k];
        a0 += c0v / (1.f + __expf(-c0v)) * wv; a1 += c1 / (1.f + __expf(-c1)) * wv; a2 += c2 / (1.f + __expf(-c2)) * wv;
        a3 += c3 / (1.f + __expf(-c3)) * wv; a4 += c4 / (1.f + __expf(-c4)) * wv;
      }
      __syncthreads();
      red[(kq * 5 + 0) * 64 + col] = a0; red[(kq * 5 + 1) * 64 + col] = a1; red[(kq * 5 + 2) * 64 + col] = a2;
      red[(kq * 5 + 3) * 64 + col] = a3; red[(kq * 5 + 4) * 64 + col] = a4;
      __syncthreads();
      for (int i = tid; i < 320; i += 256) {
        int cd = i >> 6, cc = i & 63;
        float s = red[(0 * 5 + cd) * 64 + cc] + red[(1 * 5 + cd) * 64 + cc] + red[(2 * 5 + cd) * 64 + cc] + red[(3 * 5 + cd) * 64 + cc];
        mod[(size_t)(l * 5 + cd) * 6144 + c0 + cc] = s + IN(p, I_BADA)[l * 6144 + c0 + cc];
      }
    }
    __syncthreads();
  }
  for (int j = 0; j < 26; j++) {
    const float* src; bf16_t* dst; int K, N;
    if (j < 2)       { src = IN(p, I_WINE) + (size_t)j * 1024 * 2144; dst = (bf16_t*)(ws + OFF_WINE) + (size_t)j * 2176 * 1024; K = 1024; N = 2144; }
    else if (j < 4)  { int e = j - 2; src = IN(p, I_WUQ) + (size_t)e * 256 * 1024; dst = (bf16_t*)(ws + OFF_WUQ) + (size_t)e * 1024 * 256; K = 256; N = 1024; }
    else if (j < 6)  { int e = j - 4; src = IN(p, I_WUK) + (size_t)e * 256 * 512; dst = (bf16_t*)(ws + OFF_WUK) + (size_t)e * 512 * 256; K = 256; N = 512; }
    else if (j < 8)  { int e = j - 6; src = IN(p, I_WUV) + (size_t)e * 256 * 512; dst = (bf16_t*)(ws + OFF_WUV) + (size_t)e * 512 * 256; K = 256; N = 512; }
    else if (j < 10) { int e = j - 8; src = IN(p, I_WOE) + (size_t)e * 1024 * 1024; dst = (bf16_t*)(ws + OFF_WOE) + (size_t)e * 1024 * 1024; K = 1024; N = 1024; }
    else if (j < 12) { int o = j - 10; src = IN(p, I_WINO) + (size_t)o * 1024 * 1280; dst = (bf16_t*)(ws + OFF_WINO) + (size_t)o * 1280 * 1024; K = 1024; N = 1280; }
    else if (j < 20) { int g = j - 12; src = IN(p, I_WPOOL) + (size_t)g * 16384; dst = (bf16_t*)(ws + OFF_WPOOL) + (size_t)g * 16384; K = 128; N = 128; }
    else if (j < 22) { int o = j - 20; src = IN(p, I_WOO) + (size_t)o * 1024 * 1024; dst = (bf16_t*)(ws + OFF_WOO) + (size_t)o * 1024 * 1024; K = 1024; N = 1024; }
    else             { int l = j - 22; src = IN(p, I_PWQ) + (size_t)l * 1024 * 2048; dst = (bf16_t*)(ws + OFF_WQ) + (size_t)l * 2048 * 1024; K = 1024; N = 2048; }
    transpose_cvt(src, dst, K, N, smem);
  }
  for (int i = blockIdx.x * 256 + tid; i < 2 * 32 * 1024 / 8; i += gridDim.x * 256) {
    int e = i / (32 * 128), r = i % (32 * 128);
    *(u32x4*)((bf16_t*)(ws + OFF_WINE) + ((size_t)e * 2176 + 2144) * 1024 + (size_t)r * 8) = mk4(0, 0, 0, 0);
  }
  cvt_bf16(IN(p, I_PSK), (bf16_t*)(ws + OFF_SK), (size_t)4 * 8 * 2 * 128 * 128 / 8);
  cvt_fp8_rows(IN(p, I_PU), ws + OFF_U, (float*)(ws + OFF_USC), 4 * 16384);
  cvt_fp8_rows(IN(p, I_PV), ws + OFF_V, (float*)(ws + OFF_VSC), 4 * 16384);
}

DEV void phase_norm(const P& p, int l, int sub) {
  const int lane = TID() & 63, wave = TID() >> 6;
  const float* x = OUT(p);
  const float* g = IN(p, I_GNORM) + (size_t)(l * 2 + sub) * 1024;
  const float* mod = (const float*)(WS(p) + OFF_MOD);
  bf16_t* H = (bf16_t*)(WS(p) + OFF_H);
  for (int tok = blockIdx.x * 4 + wave; tok < TT; tok += gridDim.x * 4) {
    const float* xr = (l == 0 && sub == 0) ? (tok < TP ? IN(p, I_XP) + (size_t)tok * 1024 : IN(p, I_XS) + (size_t)(tok - TP) * 1024) : x + (size_t)tok * 1024;
    float4 v[4]; float ss = 0;
#pragma unroll
    for (int i = 0; i < 4; i++) { v[i] = *(const float4*)(xr + i * 256 + lane * 4); ss += v[i].x * v[i].x + v[i].y * v[i].y + v[i].z * v[i].z + v[i].w * v[i].w; }
#pragma unroll
    for (int o = 32; o >= 1; o >>= 1) ss += __shfl_xor(ss, o);
    const float rstd = rsqrtf(ss * (1.f / 1024.f) + EPS);
    const float* mb = mod + (size_t)(l * 5 + cond_of(tok)) * 6144 + sub * 3072;
    f32x4 ov[4]; float am = 0.f;
#pragma unroll
    for (int i = 0; i < 4; i++) {
      int c = i * 256 + lane * 4;
      float4 gg = *(const float4*)(g + c), sh = *(const float4*)(mb + c), sc = *(const float4*)(mb + 1024 + c);
      f32x4 o;
      o[0] = v[i].x * rstd * gg.x * (1.f + sc.x) + sh.x; o[1] = v[i].y * rstd * gg.y * (1.f + sc.y) + sh.y;
      o[2] = v[i].z * rstd * gg.z * (1.f + sc.z) + sh.z; o[3] = v[i].w * rstd * gg.w * (1.f + sc.w) + sh.w;
      *(u32x2*)(H + (size_t)tok * 1024 + c) = pack4(o);
      ov[i] = o; am = fmaxf(am, fmaxf(fmaxf(fabsf(o[0]), fabsf(o[1])), fmaxf(fabsf(o[2]), fabsf(o[3]))));
    }
    if (sub == 1) {
#pragma unroll
      for (int o = 32; o >= 1; o >>= 1) am = fmaxf(am, __shfl_xor(am, o));
      const float q = am > 0.f ? 440.f / am : 1.f;
      unsigned char* h8 = WS(p) + OFF_H8 + (size_t)tok * 1024;
#pragma unroll
      for (int i = 0; i < 4; i++) {
        int t = 0;
        t = __builtin_amdgcn_cvt_pk_fp8_f32(ov[i][0] * q, ov[i][1] * q, t, false);
        t = __builtin_amdgcn_cvt_pk_fp8_f32(ov[i][2] * q, ov[i][3] * q, t, true);
        *(int*)(h8 + i * 256 + lane * 4) = t;
      }
      if (lane == 0) ((float*)(WS(p) + OFF_HSC))[tok] = am > 0.f ? am / 440.f : 1.f;
    }
  }
}

DEV void phase_winctx(const P& p, int o) {
  bf16_t* KS = (bf16_t*)(WS(p) + OFF_KS); bf16_t* VTS = (bf16_t*)(WS(p) + OFF_VTS);
  const float* cw = IN(p, I_CWIN);
  for (int i = blockIdx.x * 256 + TID(); i < 4 * 512 * 128; i += gridDim.x * 256) {
    int d = i & 63, hk = (i >> 6) & 1, pp = (i >> 7) & 511, b = i >> 16;
    float kv = cw[((((size_t)(b * 2 + o) * 2 + 0) * 512 + pp) * 2 + hk) * 64 + d];
    float vv = cw[((((size_t)(b * 2 + o) * 2 + 1) * 512 + pp) * 2 + hk) * 64 + d];
    KS[((size_t)b * 4608 + 4096 + pp) * 128 + hk * 64 + d] = (bf16_t)f2bf_u(kv);
    VTS[((size_t)(b * 2 + hk) * 64 + d) * 4608 + 4096 + pp] = (bf16_t)f2bf_u(vv);
  }
}


template <int AMODE>
DEV void gemm_gload(u32x4 (&ra)[4], u32x4 (&rb)[4], const bf16_t* __restrict__ A, int lda, const bf16_t* __restrict__ Bt, int ldb,
                    int m0, int n0, int k0, int pg) {
  const int tid = TID();
#pragma unroll
  for (int i = 0; i < 4; i++) {
    const int c = tid + 256 * i, r = c >> 3, kc = (c & 7) * 8;
    rb[i] = *(const u32x4*)(Bt + (size_t)(n0 + r) * ldb + k0 + kc);
    if (AMODE == 0) ra[i] = *(const u32x4*)(A + (size_t)(m0 + r) * lda + k0 + kc);
    else {
      const int t = m0 + r; int sbase, pos, len;
      if (t < TP) { sbase = t & ~255; pos = t & 255; len = 256; }
      else { int tt = t - TP; sbase = TP + (tt & ~4095); pos = tt & 4095; len = 4096; }
      const int w = 2 << pg; int lo = pos - (w >> 1), hi = lo + w; lo = lo < 0 ? 0 : lo; hi = hi > len ? len : hi;
      const int ch = pg * 128 + k0 + kc;
      float s0 = 0, s1 = 0, s2 = 0, s3 = 0, s4 = 0, s5 = 0, s6 = 0, s7 = 0;
      for (int q = lo; q < hi; q++) {
        u32x4 u = *(const u32x4*)(A + (size_t)(sbase + q) * lda + ch);
        s0 += lo2f(u.x); s1 += hi2f(u.x); s2 += lo2f(u.y); s3 += hi2f(u.y);
        s4 += lo2f(u.z); s5 += hi2f(u.z); s6 += lo2f(u.w); s7 += hi2f(u.w);
      }
      const float ic = 1.f / (float)(hi - lo);
      u32x4 u = *(const u32x4*)(A + (size_t)t * lda + ch);
      u32x4 o;
      o.x = pack2(s0 * ic - lo2f(u.x), s1 * ic - hi2f(u.x)); o.y = pack2(s2 * ic - lo2f(u.y), s3 * ic - hi2f(u.y));
      o.z = pack2(s4 * ic - lo2f(u.z), s5 * ic - hi2f(u.z)); o.w = pack2(s6 * ic - lo2f(u.w), s7 * ic - hi2f(u.w));
      ra[i] = o;
    }
  }
}

DEV void gemm_lds_store(const u32x4 (&ra)[4], const u32x4 (&rb)[4], bf16_t* An, bf16_t* Bn, int tid) {
#pragma unroll
  for (int i = 0; i < 4; i++) {
    const int c = tid + 256 * i, r = c >> 3, kc = (c & 7) * 8;
    *(u32x4*)(An + r * 72 + kc) = ra[i];
    *(u32x4*)(Bn + r * 72 + kc) = rb[i];
  }
}
DEV void gemm_compute(f32x4 (&acc)[2][8], const bf16_t* Ac, const bf16_t* Bc, int wave, int l15, int quad) {
  u32x4 af0[2], bf0[8], af1[2], bf1[8];
#pragma unroll
  for (int mt = 0; mt < 2; mt++) af0[mt] = *(const u32x4*)(Ac + (wave * 32 + mt * 16 + l15) * 72 + quad * 8);
#pragma unroll
  for (int nt = 0; nt < 8; nt++) bf0[nt] = *(const u32x4*)(Bc + (nt * 16 + l15) * 72 + quad * 8);
#pragma unroll
  for (int mt = 0; mt < 2; mt++) af1[mt] = *(const u32x4*)(Ac + (wave * 32 + mt * 16 + l15) * 72 + 32 + quad * 8);
#pragma unroll
  for (int nt = 0; nt < 8; nt++) bf1[nt] = *(const u32x4*)(Bc + (nt * 16 + l15) * 72 + 32 + quad * 8);
  __builtin_amdgcn_sched_barrier(0);
#pragma unroll
  for (int nt = 0; nt < 8; nt++)
#pragma unroll
    for (int mt = 0; mt < 2; mt++) acc[mt][nt] = mfma16(bf0[nt], af0[mt], acc[mt][nt]);
#pragma unroll
  for (int nt = 0; nt < 8; nt++)
#pragma unroll
    for (int mt = 0; mt < 2; mt++) acc[mt][nt] = mfma16(bf1[nt], af1[mt], acc[mt][nt]);
  __builtin_amdgcn_sched_barrier(0);
}

template <int AMODE>
DEV void gemm_main(f32x4 (&acc)[2][8], const bf16_t* __restrict__ A, int lda, const bf16_t* __restrict__ Bt, int ldb,
                   int K, int m0, int n0, unsigned char* smem, int pg) {
  const int tid = TID(), lane = tid & 63, wave = tid >> 6, l15 = lane & 15, quad = lane >> 4;
  bf16_t* A0 = (bf16_t*)smem; bf16_t* B0 = A0 + 128 * 72; bf16_t* A1 = A0 + 2 * 128 * 72; bf16_t* B1 = B0 + 2 * 128 * 72;
#pragma unroll
  for (int i = 0; i < 2; i++)
#pragma unroll
    for (int j = 0; j < 8; j++) acc[i][j] = (f32x4){0.f, 0.f, 0.f, 0.f};
  u32x4 ra0[4], rb0[4], ra1[4], rb1[4];
  const int nk = K >> 6;
  gemm_gload<AMODE>(ra0, rb0, A, lda, Bt, ldb, m0, n0, 0, pg);
  if (nk > 1) gemm_gload<AMODE>(ra1, rb1, A, lda, Bt, ldb, m0, n0, 64, pg);
  __syncthreads();
  gemm_lds_store(ra0, rb0, A0, B0, tid);
  __syncthreads();
  for (int k = 0; k < nk; k += 2) {
    if (k + 2 < nk) gemm_gload<AMODE>(ra0, rb0, A, lda, Bt, ldb, m0, n0, (k + 2) * 64, pg);
    gemm_compute(acc, A0, B0, wave, l15, quad);
    if (k + 1 < nk) gemm_lds_store(ra1, rb1, A1, B1, tid);
    __syncthreads();
    if (k + 1 < nk) {
      if (k + 3 < nk) gemm_gload<AMODE>(ra1, rb1, A, lda, Bt, ldb, m0, n0, (k + 3) * 64, pg);
      gemm_compute(acc, A1, B1, wave, l15, quad);
      if (k + 2 < nk) gemm_lds_store(ra0, rb0, A0, B0, tid);
      __syncthreads();
    }
  }
}


DEV void gemm_gload_big(u32x4 (&ra)[8], u32x4 (&rb)[4], const bf16_t* __restrict__ A, int lda, const bf16_t* __restrict__ Bt, int ldb,
                        int m0, int n0, int k0) {
  const int tid = TID();
#pragma unroll
  for (int i = 0; i < 8; i++) { const int c = tid + 256 * i, r = c >> 3, kc = (c & 7) * 8; ra[i] = *(const u32x4*)(A + (size_t)(m0 + r) * lda + k0 + kc); }
#pragma unroll
  for (int i = 0; i < 4; i++) { const int c = tid + 256 * i, r = c >> 3, kc = (c & 7) * 8; rb[i] = *(const u32x4*)(Bt + (size_t)(n0 + r) * ldb + k0 + kc); }
}
DEV void gemm_main_big(f32x4 (&acc)[4][8], const bf16_t* __restrict__ A, int lda, const bf16_t* __restrict__ Bt, int ldb,
                       int K, int m0, int n0, unsigned char* smem) {
  const int tid = TID(), lane = tid & 63, wave = tid >> 6, l15 = lane & 15, quad = lane >> 4;
  bf16_t* As = (bf16_t*)smem; bf16_t* Bs = As + 256 * 72;
#pragma unroll
  for (int i = 0; i < 4; i++)
#pragma unroll
    for (int j = 0; j < 8; j++) acc[i][j] = (f32x4){0.f, 0.f, 0.f, 0.f};
  u32x4 ra[8], rb[4];
  gemm_gload_big(ra, rb, A, lda, Bt, ldb, m0, n0, 0);
  for (int k0 = 0; k0 < K; k0 += 64) {
    __syncthreads();
#pragma unroll
    for (int i = 0; i < 8; i++) { const int c = tid + 256 * i, r = c >> 3, kc = (c & 7) * 8; *(u32x4*)(As + r * 72 + kc) = ra[i]; }
#pragma unroll
    for (int i = 0; i < 4; i++) { const int c = tid + 256 * i, r = c >> 3, kc = (c & 7) * 8; *(u32x4*)(Bs + r * 72 + kc) = rb[i]; }
    __syncthreads();
    if (k0 + 64 < K) gemm_gload_big(ra, rb, A, lda, Bt, ldb, m0, n0, k0 + 64);
#pragma unroll
    for (int ks = 0; ks < 2; ks++) {
      u32x4 af[4], bf[8];
#pragma unroll
      for (int mt = 0; mt < 4; mt++) af[mt] = *(const u32x4*)(As + (wave * 64 + mt * 16 + l15) * 72 + ks * 32 + quad * 8);
#pragma unroll
      for (int nt = 0; nt < 8; nt++) bf[nt] = *(const u32x4*)(Bs + (nt * 16 + l15) * 72 + ks * 32 + quad * 8);
      __builtin_amdgcn_sched_barrier(0);
#pragma unroll
      for (int nt = 0; nt < 8; nt++)
#pragma unroll
        for (int mt = 0; mt < 4; mt++) acc[mt][nt] = mfma16(bf[nt], af[mt], acc[mt][nt]);
      __builtin_amdgcn_sched_barrier(0);
    }
  }
}

DEV void rope4f(f32x4& X0, f32x4& X1, f32x4& X2, f32x4& X3, int pos, const float* ropeT, int quad) {
  const int rr = pos >> 6, cc = pos & 63;
  const f32x4 cr = *(const f32x4*)(ropeT + rr * 16 + quad * 4), sr = *(const f32x4*)(ropeT + 1024 + rr * 16 + quad * 4);
  const f32x4 c2 = *(const f32x4*)(ropeT + cc * 16 + quad * 4), s2 = *(const f32x4*)(ropeT + 1024 + cc * 16 + quad * 4);
#pragma unroll
  for (int j = 0; j < 4; j++) {
    float a0 = X0[j], a1 = X1[j]; X0[j] = a0 * cr[j] - a1 * sr[j]; X1[j] = a1 * cr[j] + a0 * sr[j];
    float b0 = X2[j], b1 = X3[j]; X2[j] = b0 * c2[j] - b1 * s2[j]; X3[j] = b1 * c2[j] + b0 * s2[j];
  }
}
#define ROPE4(X0, X1, X2, X3, pos_) rope4f(X0, X1, X2, X3, pos_, ropeT, quad);

enum { EPI_EVEN_IN = 0, EPI_ODD_IN, EPI_UQ, EPI_UK, EPI_UV, EPI_OUT, EPI_POOL, EPI_PQ };

template <int AMODE>
DEV void gemm_run(f32x4 (&acc)[2][8], const bf16_t* A, int lda, const bf16_t* Bt, int ldb, int K, int m0, int n0, unsigned char* smem, int pg) {
  gemm_main<AMODE>(acc, A, lda, Bt, ldb, K, m0, n0, smem, pg);
}
template <int AMODE>
DEV void gemm_run(f32x4 (&acc)[4][8], const bf16_t* A, int lda, const bf16_t* Bt, int ldb, int K, int m0, int n0, unsigned char* smem, int pg) {
  gemm_main_big(acc, A, lda, Bt, ldb, K, m0, n0, smem);
}

template <int EPI, int AMODE, int MT>
DEV void gemm_tile(const P& p, int l, const bf16_t* A, int lda, const bf16_t* Bt, int ldb, int K, int m0, int n0, unsigned char* smem, int pg) {
  f32x4 acc[MT][8];
  gemm_run<AMODE>(acc, A, lda, Bt, ldb, K, m0, n0, smem, pg);
  const int lane = TID() & 63, wave = TID() >> 6, l15 = lane & 15, quad = lane >> 4;
  unsigned char* ws = WS(p);
  const float* ropeT = (const float*)(ws + OFF_ROPE);
  const int e = l >> 1;
  if (EPI == EPI_EVEN_IN) {
    bf16_t* PROJ = (bf16_t*)(ws + OFF_PROJ); float* RAW = (float*)(ws + OFF_RAW);
#pragma unroll
    for (int mt = 0; mt < MT; mt++) {
      const int row = m0 + wave * (MT * 16) + mt * 16 + l15;
#pragma unroll
      for (int nt = 0; nt < 8; nt++) {
        const int col = n0 + nt * 16 + quad * 4;
        f32x4 v = acc[mt][nt];
        if (col < 1568) {
          if (col < 256) { v[0] *= 0.125f; v[1] *= 0.125f; v[2] *= 0.125f; v[3] *= 0.125f; }
          *(u32x2*)(PROJ + (size_t)row * 1568 + col) = pack4(v);
        } else if (col < 2144) {
          *(f32x4*)(RAW + (size_t)row * 576 + (col - 1568)) = v;
        }
      }
    }
  } else if (EPI == EPI_ODD_IN) {
    const int nb = n0 >> 7;
#pragma unroll
    for (int mt = 0; mt < MT; mt++) {
      const int row = m0 + wave * (MT * 16) + mt * 16 + l15;
      const bool samp = row >= TP;
      const int b = samp ? (row - TP) >> 12 : row >> 8;
      const int pos = samp ? (row - TP) & 4095 : row & 255;
      if (nb < 4) {
        bf16_t* XC = (bf16_t*)(ws + OFF_PROJ);
#pragma unroll
        for (int nt = 0; nt < 8; nt++) *(u32x2*)(XC + (size_t)row * 512 + n0 + nt * 16 + quad * 4) = pack4(acc[mt][nt]);
      } else if (nb < 9) {
        const float* g = (nb < 8 ? IN(p, I_GWQN) : IN(p, I_GWKN)) + e * 64;
#pragma unroll
        for (int hh = 0; hh < 2; hh++) {
          f32x4 x0 = acc[mt][hh * 4 + 0], x1 = acc[mt][hh * 4 + 1], x2 = acc[mt][hh * 4 + 2], x3 = acc[mt][hh * 4 + 3];
          float ss = 0;
#pragma unroll
          for (int j = 0; j < 4; j++) ss += x0[j] * x0[j] + x1[j] * x1[j] + x2[j] * x2[j] + x3[j] * x3[j];
          ss += __shfl_xor(ss, 16); ss += __shfl_xor(ss, 32);
          const float rstd = rsqrtf(ss * (1.f / 64.f) + EPS);
          const f32x4 g0 = *(const f32x4*)(g + quad * 4), g1 = *(const f32x4*)(g + 16 + quad * 4), g2 = *(const f32x4*)(g + 32 + quad * 4), g3 = *(const f32x4*)(g + 48 + quad * 4);
#pragma unroll
          for (int j = 0; j < 4; j++) { x0[j] *= rstd * g0[j]; x1[j] *= rstd * g1[j]; x2[j] *= rstd * g2[j]; x3[j] *= rstd * g3[j]; }
          if (nb < 8) {
            const int head = (nb - 4) * 2 + hh;
            if (samp) ROPE4(x0, x1, x2, x3, pos)
            bf16_t* q = (bf16_t*)(ws + OFF_QB) + (size_t)row * 512 + head * 64 + quad * 4;
            *(u32x2*)(q) = pack4(x0); *(u32x2*)(q + 16) = pack4(x1); *(u32x2*)(q + 32) = pack4(x2); *(u32x2*)(q + 48) = pack4(x3);
          } else {
            const int hk = hh;
            if (!samp) {
              float* o = OUT(p) + OUT_WIN + ((((size_t)(b * 2 + e) * 2 + 0) * 256 + pos) * 2 + hk) * 64 + quad * 4;
              *(f32x4*)(o) = x0; *(f32x4*)(o + 16) = x1; *(f32x4*)(o + 32) = x2; *(f32x4*)(o + 48) = x3;
              bf16_t* k = (bf16_t*)(ws + OFF_KP) + ((size_t)b * 256 + pos) * 128 + hk * 64 + quad * 4;
              *(u32x2*)(k) = pack4(x0); *(u32x2*)(k + 16) = pack4(x1); *(u32x2*)(k + 32) = pack4(x2); *(u32x2*)(k + 48) = pack4(x3);
            } else {
              ROPE4(x0, x1, x2, x3, pos)
              bf16_t* k = (bf16_t*)(ws + OFF_KS) + ((size_t)b * 4608 + pos) * 128 + hk * 64 + quad * 4;
              *(u32x2*)(k) = pack4(x0); *(u32x2*)(k + 16) = pack4(x1); *(u32x2*)(k + 32) = pack4(x2); *(u32x2*)(k + 48) = pack4(x3);
            }
          }
        }
      } else {
#pragma unroll
        for (int nt = 0; nt < 8; nt++) {
          const int hk = nt >> 2, d = (nt & 3) * 16 + quad * 4;
          const f32x4 v = acc[mt][nt];
          if (!samp) {
            *(f32x4*)(OUT(p) + OUT_WIN + ((((size_t)(b * 2 + e) * 2 + 1) * 256 + pos) * 2 + hk) * 64 + d) = v;
            bf16_t* vt = (bf16_t*)(ws + OFF_VTP) + ((size_t)(b * 2 + hk) * 64 + d) * 256 + pos;
#pragma unroll
            for (int j = 0; j < 4; j++) vt[(size_t)j * 256] = (bf16_t)f2bf_u(v[j]);
          } else {
            bf16_t* vt = (bf16_t*)(ws + OFF_VTS) + ((size_t)(b * 2 + hk) * 64 + d) * 4608 + pos;
#pragma unroll
            for (int j = 0; j < 4; j++) vt[(size_t)j * 4608] = (bf16_t)f2bf_u(v[j]);
          }
        }
      }
    }
  } else if (EPI == EPI_UQ) {
    const int head = n0 >> 7;
    const float* g = IN(p, I_GQN) + e * 128;
#pragma unroll
    for (int mt = 0; mt < MT; mt++) {
      const int row = m0 + wave * (MT * 16) + mt * 16 + l15;
      const bool samp = row >= TP;
      const int pos = (row - TP) & 4095;
      float ss = 0;
#pragma unroll
      for (int nt = 0; nt < 8; nt++)
#pragma unroll
        for (int j = 0; j < 4; j++) ss += acc[mt][nt][j] * acc[mt][nt][j];
      ss += __shfl_xor(ss, 16); ss += __shfl_xor(ss, 32);
      const float rstd = rsqrtf(ss * (1.f / 128.f) + EPS);
#pragma unroll
      for (int nt = 0; nt < 8; nt++) {
        const f32x4 gg = *(const f32x4*)(g + nt * 16 + quad * 4);
#pragma unroll
        for (int j = 0; j < 4; j++) acc[mt][nt][j] *= rstd * gg[j];
      }
      if (samp) ROPE4(acc[mt][4], acc[mt][5], acc[mt][6], acc[mt][7], pos)
      bf16_t* q = (bf16_t*)(ws + OFF_QB) + (size_t)row * 1024 + head * 128 + quad * 4;
#pragma unroll
      for (int nt = 0; nt < 8; nt++) *(u32x2*)(q + nt * 16) = pack4(acc[mt][nt]);
    }
  } else if (EPI == EPI_UK) {
    const int hp = n0 >> 7;
    const float* g = IN(p, I_GKN) + e * 128;
#pragma unroll
    for (int mt = 0; mt < MT; mt++) {
      const int row = m0 + wave * (MT * 16) + mt * 16 + l15;
      const float* krp; bf16_t* kdst; bool rope = false; int pos = 0;
      if (row < TP) { krp = (const float*)(ws + OFF_RAW) + (size_t)row * 576 + 512; kdst = (bf16_t*)(ws + OFF_KP) + (size_t)row * 1024; }
      else if (row < TT) { int b = (row - TP) >> 12; pos = (row - TP) & 4095; rope = true;
        krp = (const float*)(ws + OFF_RAW) + (size_t)row * 576 + 512; kdst = (bf16_t*)(ws + OFF_KS) + ((size_t)b * 4608 + pos) * 1024; }
      else { int r = row - TT, b = r >> 9, pp = r & 511;
        krp = IN(p, I_CKR) + ((size_t)(b * 2 + e) * 512 + pp) * 64; kdst = (bf16_t*)(ws + OFF_KS) + ((size_t)b * 4608 + 4096 + pp) * 1024; }
      f32x4 kr0 = *(const f32x4*)(krp + quad * 4), kr1 = *(const f32x4*)(krp + 16 + quad * 4), kr2 = *(const f32x4*)(krp + 32 + quad * 4), kr3 = *(const f32x4*)(krp + 48 + quad * 4);
      float krss = 0;
#pragma unroll
      for (int j = 0; j < 4; j++) krss += kr0[j] * kr0[j] + kr1[j] * kr1[j] + kr2[j] * kr2[j] + kr3[j] * kr3[j];
      const f32x4 gr0 = *(const f32x4*)(g + 64 + quad * 4), gr1 = *(const f32x4*)(g + 80 + quad * 4), gr2 = *(const f32x4*)(g + 96 + quad * 4), gr3 = *(const f32x4*)(g + 112 + quad * 4);
#pragma unroll
      for (int hh = 0; hh < 2; hh++) {
        float ss = krss;
#pragma unroll
        for (int u = 0; u < 4; u++)
#pragma unroll
          for (int j = 0; j < 4; j++) ss += acc[mt][hh * 4 + u][j] * acc[mt][hh * 4 + u][j];
        ss += __shfl_xor(ss, 16); ss += __shfl_xor(ss, 32);
        const float rstd = rsqrtf(ss * (1.f / 128.f) + EPS);
        bf16_t* kd = kdst + (hp * 2 + hh) * 128 + quad * 4;
#pragma unroll
        for (int u = 0; u < 4; u++) {
          const f32x4 gg = *(const f32x4*)(g + u * 16 + quad * 4);
          f32x4 v = acc[mt][hh * 4 + u];
#pragma unroll
          for (int j = 0; j < 4; j++) v[j] *= rstd * gg[j];
          *(u32x2*)(kd + u * 16) = pack4(v);
        }
        f32x4 x0, x1, x2, x3;
#pragma unroll
        for (int j = 0; j < 4; j++) { x0[j] = kr0[j] * rstd * gr0[j]; x1[j] = kr1[j] * rstd * gr1[j]; x2[j] = kr2[j] * rstd * gr2[j]; x3[j] = kr3[j] * rstd * gr3[j]; }
        if (rope) ROPE4(x0, x1, x2, x3, pos)
        *(u32x2*)(kd + 64) = pack4(x0); *(u32x2*)(kd + 80) = pack4(x1); *(u32x2*)(kd + 96) = pack4(x2); *(u32x2*)(kd + 112) = pack4(x3);
      }
    }
  } else if (EPI == EPI_UV) {
#pragma unroll
    for (int mt = 0; mt < MT; mt++) {
      const int row = m0 + wave * (MT * 16) + mt * 16 + l15;
      bf16_t* base; size_t ld;
      if (row < TP) { int b = row >> 8, pos = row & 255; base = (bf16_t*)(ws + OFF_VTP) + (size_t)b * 8 * 64 * 256 + pos; ld = 256; }
      else if (row < TT) { int b = (row - TP) >> 12, pos = (row - TP) & 4095; base = (bf16_t*)(ws + OFF_VTS) + (size_t)b * 8 * 64 * 4608 + pos; ld = 4608; }
      else { int r = row - TT, b = r >> 9, pp = r & 511; base = (bf16_t*)(ws + OFF_VTS) + (size_t)b * 8 * 64 * 4608 + 4096 + pp; ld = 4608; }
#pragma unroll
      for (int nt = 0; nt < 8; nt++) {
        const int hd = n0 + nt * 16 + quad * 4;
#pragma unroll
        for (int j = 0; j < 4; j++) base[(size_t)(hd + j) * ld] = (bf16_t)f2bf_u(acc[mt][nt][j]);
      }
    }
  } else if (EPI == EPI_OUT) {
    const float* mod = (const float*)(ws + OFF_MOD);
#pragma unroll
    for (int mt = 0; mt < MT; mt++) {
      const int row = m0 + wave * (MT * 16) + mt * 16 + l15;
      const float* gt = mod + (size_t)(l * 5 + cond_of(row)) * 6144 + 2048;
      float* xo = OUT(p) + (size_t)row * 1024;
      const float* xi = (l == 0) ? (row < TP ? IN(p, I_XP) + (size_t)row * 1024 : IN(p, I_XS) + (size_t)(row - TP) * 1024) : xo;
#pragma unroll
      for (int nt = 0; nt < 8; nt++) {
        const int col = n0 + nt * 16 + quad * 4;
        f32x4 xv = *(const f32x4*)(xi + col); const f32x4 gg = *(const f32x4*)(gt + col);
#pragma unroll
        for (int j = 0; j < 4; j++) xv[j] += gg[j] * acc[mt][nt][j];
        *(f32x4*)(xo + col) = xv;
      }
    }
  } else if (EPI == EPI_POOL) {
    const float* sc = IN(p, I_PSCALE) + e * 512 + pg * 128;
    bf16_t* MIX = (bf16_t*)(ws + OFF_MIX);
#pragma unroll
    for (int mt = 0; mt < MT; mt++) {
      const int row = m0 + wave * (MT * 16) + mt * 16 + l15;
#pragma unroll
      for (int nt = 0; nt < 8; nt++) {
        const int col = nt * 16 + quad * 4;
        const f32x4 s = *(const f32x4*)(sc + col); f32x4 v = acc[mt][nt];
#pragma unroll
        for (int j = 0; j < 4; j++) v[j] *= s[j];
        *(u32x2*)(MIX + (size_t)row * 1024 + pg * 128 + col) = pack4(v);
      }
    }
  } else if (EPI == EPI_PQ) {
    bf16_t* PQ = (bf16_t*)(ws + OFF_ODIR);
#pragma unroll
    for (int mt = 0; mt < MT; mt++) {
      const int row = m0 + wave * (MT * 16) + mt * 16 + l15;
#pragma unroll
      for (int nt = 0; nt < 8; nt++) *(u32x2*)(PQ + (size_t)row * 2048 + n0 + nt * 16 + quad * 4) = pack4(acc[mt][nt]);
    }
  }
}

DEV void phase_mla_prep(const P& p, int e) {
  const int lane = TID() & 63, wave = TID() >> 6;
  unsigned char* ws = WS(p);
  const float* RAW = (const float*)(ws + OFF_RAW);
  bf16_t* CQN = (bf16_t*)(ws + OFF_CQN); bf16_t* CKVN = (bf16_t*)(ws + OFF_CKVN);
  const f32x4 gq = *(const f32x4*)(IN(p, I_GCQ) + e * 256 + lane * 4), gk = *(const f32x4*)(IN(p, I_GCKV) + e * 256 + lane * 4);
  for (int tok = blockIdx.x * 4 + wave; tok < TT + 2048; tok += gridDim.x * 4) {
    if (tok < TT) {
      const float* r = RAW + (size_t)tok * 576;
      f32x4 cq = *(const f32x4*)(r + lane * 4), ck = *(const f32x4*)(r + 256 + lane * 4);
      float s1 = cq[0] * cq[0] + cq[1] * cq[1] + cq[2] * cq[2] + cq[3] * cq[3];
      float s2 = ck[0] * ck[0] + ck[1] * ck[1] + ck[2] * ck[2] + ck[3] * ck[3];
#pragma unroll
      for (int o = 32; o >= 1; o >>= 1) { s1 += __shfl_xor(s1, o); s2 += __shfl_xor(s2, o); }
      const float r1 = rsqrtf(s1 * (1.f / 256.f) + EPS), r2 = rsqrtf(s2 * (1.f / 256.f) + EPS);
#pragma unroll
      for (int j = 0; j < 4; j++) { cq[j] *= r1 * gq[j]; ck[j] *= r2 * gk[j]; }
      *(u32x2*)(CQN + (size_t)tok * 256 + lane * 4) = pack4(cq);
      *(u32x2*)(CKVN + (size_t)tok * 256 + lane * 4) = pack4(ck);
      if (tok < TP) {
        const int b = tok >> 8, pos = tok & 255;
        *(f32x4*)(OUT(p) + OUT_CKV + ((size_t)(b * 2 + e) * 256 + pos) * 256 + lane * 4) = ck;
        if (lane < 16) *(f32x4*)(OUT(p) + OUT_KR + ((size_t)(b * 2 + e) * 256 + pos) * 64 + lane * 4) = *(const f32x4*)(r + 512 + lane * 4);
      }
    } else {
      const int rr = tok - TT, b = rr >> 9, pp = rr & 511;
      const f32x4 v = *(const f32x4*)(IN(p, I_CCKV) + ((size_t)(b * 2 + e) * 512 + pp) * 256 + lane * 4);
      *(u32x2*)(CKVN + (size_t)tok * 256 + lane * 4) = pack4(v);
    }
  }
}


template <int DQ>
DEV void att_load(u32x4 (&kr)[DQ / 32], u32x4 (&vr)[2], const bf16_t* __restrict__ Kb, int k_ld, const bf16_t* __restrict__ Vt, int v_ld, int ks0) {
  constexpr int NKS = DQ / 32, CPR = DQ / 8;
  const int tid = TID();
#pragma unroll
  for (int i = 0; i < NKS; i++) { const int c = tid + 256 * i, r = c / CPR, kc = (c % CPR) * 8; kr[i] = *(const u32x4*)(Kb + (size_t)(ks0 + r) * k_ld + kc); }
#pragma unroll
  for (int i = 0; i < 2; i++) { const int c = tid + 256 * i, r = c >> 3, kc = (c & 7) * 8; vr[i] = *(const u32x4*)(Vt + (size_t)r * v_ld + ks0 + kc); }
}

template <int DQ, bool WIN>
DEV void attn_tile(const bf16_t* Kc, const bf16_t* Vc, const u32x4 (&qf)[2][DQ / 32], f32x4 (&oacc)[2][4], float (&m_run)[2], float (&l_run)[2],
                   float scale2, bool masked, int kstart, int qpos0, int wave, int l15, int quad) {
  constexpr int KLD = DQ + 8, NKS = DQ / 32;
  f32x4 s[2][4];
#pragma unroll
  for (int mt = 0; mt < 2; mt++)
#pragma unroll
    for (int kt = 0; kt < 4; kt++) s[mt][kt] = (f32x4){0.f, 0.f, 0.f, 0.f};
  {
    u32x4 kf[4][NKS];
#pragma unroll
    for (int kt = 0; kt < 4; kt++)
#pragma unroll
      for (int ks = 0; ks < NKS; ks++) kf[kt][ks] = *(const u32x4*)(Kc + (kt * 16 + l15) * KLD + ks * 32 + quad * 8);
#pragma unroll
    for (int kt = 0; kt < 4; kt++)
#pragma unroll
      for (int ks = 0; ks < NKS; ks++)
#pragma unroll
        for (int mt = 0; mt < 2; mt++) s[mt][kt] = mfma16(kf[kt][ks], qf[mt][ks], s[mt][kt]);
  }
#pragma unroll
  for (int mt = 0; mt < 2; mt++) {
    float mx = -1e30f;
    const int qpos = qpos0 + wave * 32 + mt * 16 + l15;
#pragma unroll
    for (int kt = 0; kt < 4; kt++)
#pragma unroll
      for (int j = 0; j < 4; j++) {
        float v = s[mt][kt][j] * scale2;
        if (WIN && masked) { int dlt = qpos - (kstart + kt * 16 + quad * 4 + j); dlt = dlt < 0 ? -dlt : dlt; if (dlt > 128) v = -1e30f; }
        s[mt][kt][j] = v; mx = fmaxf(mx, v);
      }
    mx = fmaxf(mx, __shfl_xor(mx, 16)); mx = fmaxf(mx, __shfl_xor(mx, 32));
    const float mnew = fmaxf(m_run[mt], mx);
    const bool grew = __builtin_amdgcn_ballot_w64(mnew > m_run[mt]) != 0ull;
    float psum = 0;
#pragma unroll
    for (int kt = 0; kt < 4; kt++)
#pragma unroll
      for (int j = 0; j < 4; j++) { float pv = __builtin_amdgcn_exp2f(s[mt][kt][j] - mnew); s[mt][kt][j] = pv; psum += pv; }
    if (grew) {
      const float alpha = __builtin_amdgcn_exp2f(m_run[mt] - mnew);
      m_run[mt] = mnew;
      l_run[mt] = l_run[mt] * alpha + psum;
#pragma unroll
      for (int vt = 0; vt < 4; vt++)
#pragma unroll
        for (int j = 0; j < 4; j++) oacc[mt][vt][j] *= alpha;
    } else l_run[mt] += psum;
  }
  {
    u32x4 vf[2][4];
#pragma unroll
    for (int u = 0; u < 2; u++)
#pragma unroll
      for (int vt = 0; vt < 4; vt++) {
        const u32x2 a = *(const u32x2*)(Vc + (vt * 16 + l15) * 72 + (2 * u) * 16 + quad * 4);
        const u32x2 b = *(const u32x2*)(Vc + (vt * 16 + l15) * 72 + (2 * u + 1) * 16 + quad * 4);
        vf[u][vt] = mk4(a.x, a.y, b.x, b.y);
      }
    u32x4 pf[2][2];
#pragma unroll
    for (int u = 0; u < 2; u++)
#pragma unroll
      for (int mt = 0; mt < 2; mt++) { u32x2 a = pack4(s[mt][2 * u]), b = pack4(s[mt][2 * u + 1]); pf[u][mt] = mk4(a.x, a.y, b.x, b.y); }
#pragma unroll
    for (int u = 0; u < 2; u++)
#pragma unroll
      for (int vt = 0; vt < 4; vt++)
#pragma unroll
        for (int mt = 0; mt < 2; mt++) oacc[mt][vt] = mfma16(vf[u][vt], pf[u][mt], oacc[mt][vt]);
  }
}

template <int DQ>
DEV void att_lds_store(const u32x4 (&kr)[DQ / 32], const u32x4 (&vr)[2], bf16_t* Kn, bf16_t* Vn, int tid) {
  constexpr int KLD = DQ + 8, NKS = DQ / 32, CPR = DQ / 8;
#pragma unroll
  for (int i = 0; i < NKS; i++) { const int c = tid + 256 * i, r = c / CPR, kc = (c % CPR) * 8; *(u32x4*)(Kn + r * KLD + kc) = kr[i]; }
#pragma unroll
  for (int i = 0; i < 2; i++) { const int c = tid + 256 * i, r = c >> 3, kc = (c & 7) * 8; *(u32x4*)(Vn + r * 72 + kc) = vr[i]; }
}

template <int DQ, bool WIN>
DEV void attn_item(const bf16_t* __restrict__ Q, int q_ld, const bf16_t* __restrict__ Kb, int k_ld, const bf16_t* __restrict__ Vt, int v_ld,
                   int r1_lo, int r1_hi, int r2_lo, int r2_hi, int qpos0, float scale, float sink, bool has_sink,
                   bf16_t* __restrict__ O, int o_ld, unsigned char* smem) {
  constexpr int KLD = DQ + 8, NKS = DQ / 32;
  const int tid = TID(), lane = tid & 63, wave = tid >> 6, l15 = lane & 15, quad = lane >> 4;
  constexpr int BUFE = 64 * KLD + 64 * 72;
  bf16_t* K0 = (bf16_t*)smem; bf16_t* V0 = K0 + 64 * KLD; bf16_t* K1 = K0 + BUFE; bf16_t* V1 = V0 + BUFE;
  u32x4 qf[2][NKS];
#pragma unroll
  for (int mt = 0; mt < 2; mt++)
#pragma unroll
    for (int ks = 0; ks < NKS; ks++) qf[mt][ks] = *(const u32x4*)(Q + (size_t)(wave * 32 + mt * 16 + l15) * q_ld + ks * 32 + quad * 8);
  float m_run[2], l_run[2]; f32x4 oacc[2][4];
#pragma unroll
  for (int mt = 0; mt < 2; mt++) {
    m_run[mt] = has_sink ? sink * 1.4426950408889634f : -1e30f; l_run[mt] = (has_sink && quad == 0) ? 1.f : 0.f;
#pragma unroll
    for (int vt = 0; vt < 4; vt++) oacc[mt][vt] = (f32x4){0.f, 0.f, 0.f, 0.f};
  }
  const int n1 = (r1_hi - r1_lo) >> 6, n2 = (r2_hi - r2_lo) >> 6, ntl = n1 + n2;
  const float scale2 = scale * 1.4426950408889634f;
#define KSTART(i_) ((i_) < n1 ? r1_lo + 64 * (i_) : r2_lo + 64 * ((i_) - n1))
  u32x4 kr0[NKS], vr0[2], kr1[NKS], vr1[2];
  att_load<DQ>(kr0, vr0, Kb, k_ld, Vt, v_ld, KSTART(0));
  if (ntl > 1) att_load<DQ>(kr1, vr1, Kb, k_ld, Vt, v_ld, KSTART(1));
  __syncthreads();
  att_lds_store<DQ>(kr0, vr0, K0, V0, tid);
  __syncthreads();
  for (int it = 0; it < ntl; it += 2) {
    if (it + 2 < ntl) att_load<DQ>(kr0, vr0, Kb, k_ld, Vt, v_ld, KSTART(it + 2));
    attn_tile<DQ, WIN>(K0, V0, qf, oacc, m_run, l_run, scale2, it < n1, KSTART(it), qpos0, wave, l15, quad);
    if (it + 1 < ntl) att_lds_store<DQ>(kr1, vr1, K1, V1, tid);
    __syncthreads();
    if (it + 1 < ntl) {
      if (it + 3 < ntl) att_load<DQ>(kr1, vr1, Kb, k_ld, Vt, v_ld, KSTART(it + 3));
      attn_tile<DQ, WIN>(K1, V1, qf, oacc, m_run, l_run, scale2, it + 1 < n1, KSTART(it + 1), qpos0, wave, l15, quad);
      if (it + 2 < ntl) att_lds_store<DQ>(kr0, vr0, K0, V0, tid);
      __syncthreads();
    }
  }
#undef KSTART
#pragma unroll
  for (int mt = 0; mt < 2; mt++) {
    float lt = l_run[mt]; lt += __shfl_xor(lt, 16); lt += __shfl_xor(lt, 32);
    const float inv = 1.f / lt;
    bf16_t* o = O + (size_t)(wave * 32 + mt * 16 + l15) * o_ld + quad * 4;
#pragma unroll
    for (int vt = 0; vt < 4; vt++) {
      f32x4 v = oacc[mt][vt];
#pragma unroll
      for (int j = 0; j < 4; j++) v[j] *= inv;
      *(u32x2*)(o + vt * 16) = pack4(v);
    }
  }
}

DEV void mla_attn_item(const P& p, int item, unsigned char* smem) {
  unsigned char* ws = WS(p);
  bf16_t* MIX = (bf16_t*)(ws + OFF_MIX);
  const float scale = 0.08838834764831845f;
  if (item < 1024) {
    const int qb = item & 31, h = (item >> 5) & 7, b = item >> 8;
    const int tok0 = TP + b * 4096 + qb * 128;
    attn_item<128, false>((const bf16_t*)(ws + OFF_QB) + (size_t)tok0 * 1024 + h * 128, 1024,
                          (const bf16_t*)(ws + OFF_KS) + (size_t)b * 4608 * 1024 + h * 128, 1024,
                          (const bf16_t*)(ws + OFF_VTS) + (size_t)(b * 8 + h) * 64 * 4608, 4608,
                          0, 4608, 0, 0, 0, scale, 0.f, false, MIX + (size_t)tok0 * 1024 + 512 + h * 64, 1024, smem);
  } else {
    const int it = item - 1024, qb = it & 1, h = (it >> 1) & 7, b = it >> 4;
    const int tok0 = b * 256 + qb * 128;
    attn_item<128, false>((const bf16_t*)(ws + OFF_QB) + (size_t)tok0 * 1024 + h * 128, 1024,
                          (const bf16_t*)(ws + OFF_KP) + (size_t)b * 256 * 1024 + h * 128, 1024,
                          (const bf16_t*)(ws + OFF_VTP) + (size_t)(b * 8 + h) * 64 * 256, 256,
                          0, 256, 0, 0, 0, scale, 0.f, false, MIX + (size_t)tok0 * 1024 + 512 + h * 64, 1024, smem);
  }
}

DEV void win_attn_item(const P& p, int o, int item, unsigned char* smem) {
  unsigned char* ws = WS(p);
  bf16_t* MIX = (bf16_t*)(ws + OFF_MIX);
  if (item < 1024) {
    const int qb = item & 31, h = (item >> 5) & 7, b = item >> 8, hk = h >> 2;
    const int tok0 = TP + b * 4096 + qb * 128;
    int lo = qb * 128 - 128, hi = qb * 128 + 256; lo = lo < 0 ? 0 : lo; hi = hi > 4096 ? 4096 : hi;
    attn_item<64, true>((const bf16_t*)(ws + OFF_QB) + (size_t)tok0 * 512 + h * 64, 512,
                        (const bf16_t*)(ws + OFF_KS) + (size_t)b * 4608 * 128 + hk * 64, 128,
                        (const bf16_t*)(ws + OFF_VTS) + (size_t)(b * 2 + hk) * 64 * 4608, 4608,
                        lo, hi, 4096, 4608, qb * 128, 0.125f, IN(p, I_SINK)[o * 8 + h], true, MIX + (size_t)tok0 * 1024 + 512 + h * 64, 1024, smem);
  } else {
    const int it = item - 1024, qb = it & 1, h = (it >> 1) & 7, b = it >> 4, hk = h >> 2;
    const int tok0 = b * 256 + qb * 128;
    attn_item<64, false>((const bf16_t*)(ws + OFF_QB) + (size_t)tok0 * 512 + h * 64, 512,
                         (const bf16_t*)(ws + OFF_KP) + (size_t)b * 256 * 128 + hk * 64, 128,
                         (const bf16_t*)(ws + OFF_VTP) + (size_t)(b * 2 + hk) * 64 * 256, 256,
                         0, 256, 0, 0, 0, 0.125f, IN(p, I_SINK)[o * 8 + h], true, MIX + (size_t)tok0 * 1024 + 512 + h * 64, 1024, smem);
  }
}

template <int dir>
DEV void gla_local_d(const P& p, int e, int cg, int h, unsigned char* smem) {
  const int tid = TID(), lane = tid & 63, wave = tid >> 6, l15 = lane & 15, quad = lane >> 4;
  unsigned char* ws = WS(p);
  bf16_t* QD = (bf16_t*)smem;
  bf16_t* KI = QD + 64 * 72;
  bf16_t* KST = KI + 64 * 72;
  bf16_t* VTs = KST + 64 * 72;
  float* DEC = (float*)(VTs + 128 * 72);
  float* WUP = DEC + 64;
  float* BUP = WUP + 1024;
  const int unit = (cg * 4 + h) * 2 + dir;
  const int tok0 = cg * 64;
  const bf16_t* row = (const bf16_t*)(ws + OFF_PROJ) + (size_t)(tok0 + lane) * 1568;
  u32x4 rl[2], rq[2], rk[2], rv[4];
  rl[0] = *(const u32x4*)(row + 1536 + dir * 16); rl[1] = *(const u32x4*)(row + 1536 + dir * 16 + 8);
  rq[0] = *(const u32x4*)(row + h * 64 + wave * 16); rq[1] = *(const u32x4*)(row + h * 64 + wave * 16 + 8);
  rk[0] = *(const u32x4*)(row + 256 + h * 64 + wave * 16); rk[1] = *(const u32x4*)(row + 256 + h * 64 + wave * 16 + 8);
#pragma unroll
  for (int i = 0; i < 4; i++) rv[i] = *(const u32x4*)(row + 512 + h * 128 + (wave + 4 * i) * 8);
  __syncthreads();
  for (int i = tid; i < 1024; i += 256) WUP[i] = IN(p, I_WGU)[((size_t)(e * 2 + dir) * 16 + (i >> 6)) * 256 + h * 64 + (i & 63)];
  if (tid < 64) BUP[tid] = IN(p, I_BGU)[(size_t)(e * 2 + dir) * 256 + h * 64 + tid];
  *(u32x4*)(QD + lane * 72 + wave * 16) = rq[0]; *(u32x4*)(QD + lane * 72 + wave * 16 + 8) = rq[1];
  *(u32x4*)(KI + lane * 72 + wave * 16) = rk[0]; *(u32x4*)(KI + lane * 72 + wave * 16 + 8) = rk[1];
#pragma unroll
  for (int i = 0; i < 4; i++) {
    bf16_t* d = VTs + ((wave + 4 * i) * 8) * 72 + lane;
    d[0 * 72] = (bf16_t)(rv[i].x & 0xffff); d[1 * 72] = (bf16_t)(rv[i].x >> 16);
    d[2 * 72] = (bf16_t)(rv[i].y & 0xffff); d[3 * 72] = (bf16_t)(rv[i].y >> 16);
    d[4 * 72] = (bf16_t)(rv[i].z & 0xffff); d[5 * 72] = (bf16_t)(rv[i].z >> 16);
    d[6 * 72] = (bf16_t)(rv[i].w & 0xffff); d[7 * 72] = (bf16_t)(rv[i].w >> 16);
  }
  __syncthreads();
  {
    float low[16];
    low[0] = lo2f(rl[0].x); low[1] = hi2f(rl[0].x); low[2] = lo2f(rl[0].y); low[3] = hi2f(rl[0].y);
    low[4] = lo2f(rl[0].z); low[5] = hi2f(rl[0].z); low[6] = lo2f(rl[0].w); low[7] = hi2f(rl[0].w);
    low[8] = lo2f(rl[1].x); low[9] = hi2f(rl[1].x); low[10] = lo2f(rl[1].y); low[11] = hi2f(rl[1].y);
    low[12] = lo2f(rl[1].z); low[13] = hi2f(rl[1].z); low[14] = lo2f(rl[1].w); low[15] = hi2f(rl[1].w);
#pragma unroll 4
    for (int dd = 0; dd < 16; dd++) {
      const int col = wave * 16 + dd;
      float zz = BUP[col];
#pragma unroll
      for (int r = 0; r < 16; r++) zz += low[r] * WUP[r * 64 + col];
      float v = (fminf(zz, 0.f) - __logf(1.f + __expf(-fabsf(zz)))) * (1.f / 16.f);
      if (dir == 0) {
#pragma unroll
        for (int off = 1; off < 64; off <<= 1) { float t2 = __shfl_up(v, off); if (lane >= off) v += t2; }
      } else {
#pragma unroll
        for (int off = 1; off < 64; off <<= 1) { float t2 = __shfl_down(v, off); if (lane + off < 64) v += t2; }
      }
      const float bl = __shfl(v, dir == 0 ? 63 : 0);
      const float qv = bf2f(QD[lane * 72 + col]), kv = bf2f(KI[lane * 72 + col]);
      QD[lane * 72 + col] = (bf16_t)f2bf_u(qv * __expf(v));
      KI[lane * 72 + col] = (bf16_t)f2bf_u(kv * __expf(-v));
      KST[col * 72 + lane] = (bf16_t)f2bf_u(kv * __expf(bl - v));
      if (lane == 0) DEC[col] = __expf(bl);
    }
  }
  __syncthreads();
  {
    u32x4 qdf[2];
#pragma unroll
    for (int ks = 0; ks < 2; ks++) qdf[ks] = *(const u32x4*)(QD + (wave * 16 + l15) * 72 + ks * 32 + quad * 8);
    f32x4 a[4];
    const int ii = wave * 16 + l15;
#pragma unroll
    for (int jt = 0; jt < 4; jt++) {
      a[jt] = (f32x4){0.f, 0.f, 0.f, 0.f};
#pragma unroll
      for (int ks = 0; ks < 2; ks++) a[jt] = mfma16(*(const u32x4*)(KI + (jt * 16 + l15) * 72 + ks * 32 + quad * 8), qdf[ks], a[jt]);
#pragma unroll
      for (int j = 0; j < 4; j++) { const int jj = jt * 16 + quad * 4 + j; const bool keep = dir == 0 ? (jj <= ii) : (jj >= ii); if (!keep) a[jt][j] = 0.f; }
    }
    u32x4 pf[2];
#pragma unroll
    for (int u = 0; u < 2; u++) { u32x2 x = pack4(a[2 * u]), y = pack4(a[2 * u + 1]); pf[u] = mk4(x.x, x.y, y.x, y.y); }
    float* orow = (float*)(ws + OFF_ODIR) + (size_t)dir * TT * 512 + (size_t)(tok0 + ii) * 512 + h * 128 + quad * 4;
#pragma unroll
    for (int vt = 0; vt < 8; vt++) {
      f32x4 o = (f32x4){0.f, 0.f, 0.f, 0.f};
#pragma unroll
      for (int u = 0; u < 2; u++) {
        const u32x2 x = *(const u32x2*)(VTs + (vt * 16 + l15) * 72 + (2 * u) * 16 + quad * 4);
        const u32x2 y = *(const u32x2*)(VTs + (vt * 16 + l15) * 72 + (2 * u + 1) * 16 + quad * 4);
        o = mfma16(mk4(x.x, x.y, y.x, y.y), pf[u], o);
      }
      *(f32x4*)(orow + vt * 16) = o;
    }
  }
  {
    bf16_t* qg = (bf16_t*)(ws + OFF_QDG) + (size_t)unit * 4096;
    bf16_t* kg = (bf16_t*)(ws + OFF_KSTG) + (size_t)unit * 4096;
#pragma unroll
    for (int i = 0; i < 2; i++) {
      const int c = tid + 256 * i, r = c >> 3, kc = (c & 7) * 8;
      *(u32x4*)(qg + r * 64 + kc) = *(const u32x4*)(QD + r * 72 + kc);
      *(u32x4*)(kg + r * 64 + kc) = *(const u32x4*)(KST + r * 72 + kc);
    }
    if (tid < 64) ((float*)(ws + OFF_DECG))[(size_t)unit * 64 + tid] = DEC[tid];
    if (dir == 0) {
      bf16_t* vg = (bf16_t*)(ws + OFF_VTG) + (size_t)(cg * 4 + h) * 8192;
#pragma unroll
      for (int i = 0; i < 4; i++) {
        const int c = tid + 256 * i, r = c >> 3, kc = (c & 7) * 8;
        *(u32x4*)(vg + r * 64 + kc) = *(const u32x4*)(VTs + r * 72 + kc);
      }
    }
  }
}
DEV void gla_local(const P& p, int e, int unit, unsigned char* smem) {
  const int cg = unit >> 3, h = (unit >> 1) & 3;
  if ((unit & 1) == 0) gla_local_d<0>(p, e, cg, h, smem); else gla_local_d<1>(p, e, cg, h, smem);
}

DEV void gla_seq(const P& p, int e, int item) {
  const int tid = TID(), lane = tid & 63, wave = tid >> 6, l15 = lane & 15, quad = lane >> 4;
  unsigned char* ws = WS(p);
  const bool samp = item < 32;
  const int it0 = samp ? item : item - 32;
  const int b = it0 >> 3, h = (it0 >> 1) & 3, dir = it0 & 1;
  const int nch = samp ? 64 : 4;
  const int tok_base = samp ? TP + b * 4096 : b * 256;
  const int cg0 = tok_base >> 6;
  f32x4 sacc[4][2];
#pragma unroll
  for (int dt = 0; dt < 4; dt++)
#pragma unroll
    for (int vt2 = 0; vt2 < 2; vt2++)
#pragma unroll
      for (int j = 0; j < 4; j++)
        sacc[dt][vt2][j] = samp ? IN(p, I_SGLA)[((((size_t)(b * 2 + e) * 2 + dir) * 4 + h) * 64 + dt * 16 + quad * 4 + j) * 128 + (2 * wave + vt2) * 16 + l15] : 0.f;
  float* oint = (float*)(ws + OFF_OINT) + (size_t)dir * TT * 512;
  unsigned pfacc = 0u;
#pragma unroll 2
  for (int ci = 0; ci < nch; ci++) {
    const int ch = dir == 0 ? ci : nch - 1 - ci;
    const int cg = cg0 + ch;
    const int unit = (cg * 4 + h) * 2 + dir;
    const bf16_t* qg = (const bf16_t*)(ws + OFF_QDG) + (size_t)unit * 4096;
    const bf16_t* kg = (const bf16_t*)(ws + OFF_KSTG) + (size_t)unit * 4096;
    const bf16_t* vg = (const bf16_t*)(ws + OFF_VTG) + (size_t)(cg * 4 + h) * 8192;
    const float* dg = (const float*)(ws + OFF_DECG) + (size_t)unit * 64;
    unsigned pv = 0u;
    if (ci + 1 < nch) {
      const int chn = dir == 0 ? ci + 1 : nch - 2 - ci;
      const int cgn = cg0 + chn, unitn = (cgn * 4 + h) * 2 + dir;
      const unsigned char* pf;
      if (lane < 16) pf = ws + OFF_QDG + (size_t)unitn * 8192 + (wave * 16 + lane) * 128;
      else if (lane < 32) pf = ws + OFF_KSTG + (size_t)unitn * 8192 + (wave * 16 + lane - 16) * 128;
      else pf = ws + OFF_VTG + (size_t)(cgn * 4 + h) * 16384 + (wave * 32 + lane - 32) * 128;
      if (wave == 0 && lane < 2) pf = ws + OFF_DECG + (size_t)unitn * 256 + lane * 128;
      pv = *(const volatile unsigned*)pf;
    }
    u32x2 qa[4][2][2];
#pragma unroll
    for (int it = 0; it < 4; it++)
#pragma unroll
      for (int u = 0; u < 2; u++) {
        qa[it][u][0] = *(const u32x2*)(qg + (it * 16 + l15) * 64 + (2 * u) * 16 + quad * 4);
        qa[it][u][1] = *(const u32x2*)(qg + (it * 16 + l15) * 64 + (2 * u + 1) * 16 + quad * 4);
      }
    u32x4 kf[4][2], vf[2][2]; f32x4 dc[4];
#pragma unroll
    for (int dt = 0; dt < 4; dt++) {
      dc[dt] = *(const f32x4*)(dg + dt * 16 + quad * 4);
#pragma unroll
      for (int ks = 0; ks < 2; ks++) kf[dt][ks] = *(const u32x4*)(kg + (dt * 16 + l15) * 64 + ks * 32 + quad * 8);
    }
#pragma unroll
    for (int vt2 = 0; vt2 < 2; vt2++)
#pragma unroll
      for (int ks = 0; ks < 2; ks++) vf[vt2][ks] = *(const u32x4*)(vg + ((2 * wave + vt2) * 16 + l15) * 64 + ks * 32 + quad * 8);
    u32x4 sb[2][2];
#pragma unroll
    for (int u = 0; u < 2; u++)
#pragma unroll
      for (int vt2 = 0; vt2 < 2; vt2++) { u32x2 x = pack4(sacc[2 * u][vt2]), y = pack4(sacc[2 * u + 1][vt2]); sb[u][vt2] = mk4(x.x, x.y, y.x, y.y); }
#pragma unroll
    for (int it = 0; it < 4; it++) {
#pragma unroll
      for (int vt2 = 0; vt2 < 2; vt2++) {
        f32x4 o = (f32x4){0.f, 0.f, 0.f, 0.f};
#pragma unroll
        for (int u = 0; u < 2; u++) o = mfma16(sb[u][vt2], mk4(qa[it][u][0].x, qa[it][u][0].y, qa[it][u][1].x, qa[it][u][1].y), o);
        *(f32x4*)(oint + (size_t)(tok_base + ch * 64 + it * 16 + l15) * 512 + h * 128 + (2 * wave + vt2) * 16 + quad * 4) = o;
      }
    }
#pragma unroll
    for (int dt = 0; dt < 4; dt++)
#pragma unroll
      for (int vt2 = 0; vt2 < 2; vt2++) {
        f32x4 sv = sacc[dt][vt2];
#pragma unroll
        for (int j = 0; j < 4; j++) sv[j] *= dc[dt][j];
#pragma unroll
        for (int ks = 0; ks < 2; ks++) sv = mfma16(kf[dt][ks], vf[vt2][ks], sv);
        sacc[dt][vt2] = sv;
      }
    pfacc += pv;
  }
  if (pfacc == 0xdeadbeefu) ((unsigned*)(ws + OFF_CTR))[63] = pfacc;
  if (!samp) {
#pragma unroll
    for (int dt = 0; dt < 4; dt++)
#pragma unroll
      for (int vt2 = 0; vt2 < 2; vt2++)
#pragma unroll
        for (int j = 0; j < 4; j++)
          OUT(p)[OUT_GLA + ((((size_t)(b * 2 + e) * 2 + dir) * 4 + h) * 64 + dt * 16 + quad * 4 + j) * 128 + (2 * wave + vt2) * 16 + l15] = sacc[dt][vt2][j];
  }
}

DEV void phase_gla_out(const P& p, int e) {
  const int lane = TID() & 63, wave = TID() >> 6;
  unsigned char* ws = WS(p);
  const float* O0 = (const float*)(ws + OFF_ODIR); const float* O1 = O0 + (size_t)TT * 512;
  const float* I0 = (const float*)(ws + OFF_OINT); const float* I1 = I0 + (size_t)TT * 512;
  const bf16_t* PROJ = (const bf16_t*)(ws + OFF_PROJ);
  bf16_t* MIX = (bf16_t*)(ws + OFF_MIX);
  const float* g = IN(p, I_GGO) + e * 128 + (lane & 15) * 8;
  const f32x4 g0 = *(const f32x4*)g, g1 = *(const f32x4*)(g + 4);
  for (int tok = blockIdx.x * 4 + wave; tok < TT; tok += gridDim.x * 4) {
    const size_t off = (size_t)tok * 512 + lane * 8;
    f32x4 a0 = *(const f32x4*)(O0 + off), a1 = *(const f32x4*)(O0 + off + 4);
    const f32x4 b0 = *(const f32x4*)(O1 + off), b1 = *(const f32x4*)(O1 + off + 4);
    const f32x4 c0 = *(const f32x4*)(I0 + off), c1 = *(const f32x4*)(I0 + off + 4);
    const f32x4 d0 = *(const f32x4*)(I1 + off), d1 = *(const f32x4*)(I1 + off + 4);
    float ss = 0;
#pragma unroll
    for (int j = 0; j < 4; j++) { a0[j] += b0[j] + c0[j] + d0[j]; a1[j] += b1[j] + c1[j] + d1[j]; ss += a0[j] * a0[j] + a1[j] * a1[j]; }
    ss += __shfl_xor(ss, 1); ss += __shfl_xor(ss, 2); ss += __shfl_xor(ss, 4); ss += __shfl_xor(ss, 8);
    const float rstd = rsqrtf(ss * (1.f / 128.f) + EPS);
    const u32x4 ru = *(const u32x4*)(PROJ + (size_t)tok * 1568 + 1024 + lane * 8);
    float ra[8] = {lo2f(ru.x), hi2f(ru.x), lo2f(ru.y), hi2f(ru.y), lo2f(ru.z), hi2f(ru.z), lo2f(ru.w), hi2f(ru.w)};
    float o[8];
#pragma unroll
    for (int j = 0; j < 4; j++) {
      o[j] = a0[j] * rstd * g0[j] * (ra[j] / (1.f + __expf(-ra[j])));
      o[4 + j] = a1[j] * rstd * g1[j] * (ra[4 + j] / (1.f + __expf(-ra[4 + j])));
    }
    u32x4 w; w.x = pack2(o[0], o[1]); w.y = pack2(o[2], o[3]); w.z = pack2(o[4], o[5]); w.w = pack2(o[6], o[7]);
    *(u32x4*)(MIX + (size_t)tok * 1024 + lane * 8) = w;
  }
}

DEV void topk_insert(float (&L)[16], float x) {
#pragma unroll
  for (int i = 15; i >= 1; i--) L[i] = __builtin_amdgcn_fmed3f(L[i - 1], L[i], x);
  L[0] = fmaxf(L[0], x);
}
#define TOPK_INSERT(L, x_) topk_insert(L, x_);

DEV void phase_peer_select(const P& p, int l, unsigned char* smem) {
  const int tid = TID(), lane = tid & 63, wave = tid >> 6, l15 = lane & 15, quad = lane >> 4;
  unsigned char* ws = WS(p);
  float* TOP = (float*)smem;
  float* SC = (float*)(smem + 32768) + wave * (64 * 33);
  const bf16_t* PQ = (const bf16_t*)(ws + OFF_ODIR);
  const bf16_t* SK = (const bf16_t*)(ws + OFF_SK) + (size_t)l * 8 * 2 * 128 * 128;
  int* SELI = (int*)(ws + OFF_SELI); float* SELG = (float*)(ws + OFF_SELG);
  for (int tile = blockIdx.x; tile < TT / 32; tile += gridDim.x) {
    const int tok0 = tile * 32;
    for (int hh = 0; hh < 2; hh++) {
      const int h = wave * 2 + hh;
      float L[16];
#pragma unroll
      for (int i = 0; i < 16; i++) L[i] = -3.0e38f;
      u32x4 qf[2][2][4];
#pragma unroll
      for (int c = 0; c < 2; c++)
#pragma unroll
        for (int mt = 0; mt < 2; mt++)
#pragma unroll
          for (int ks = 0; ks < 4; ks++)
            qf[c][mt][ks] = *(const u32x4*)(PQ + (size_t)(tok0 + mt * 16 + l15) * 2048 + h * 256 + c * 128 + ks * 32 + quad * 8);
      u32x4 sf[2][2][4];
#pragma unroll
      for (int c = 0; c < 2; c++)
#pragma unroll
        for (int kt = 0; kt < 2; kt++)
#pragma unroll
          for (int ks = 0; ks < 4; ks++)
            sf[c][kt][ks] = *(const u32x4*)(SK + ((size_t)(h * 2 + c) * 128 + kt * 16 + l15) * 128 + ks * 32 + quad * 8);
#pragma unroll 1
      for (int qt = 0; qt < 4; qt++) {
        asm volatile("s_waitcnt lgkmcnt(0)" ::: "memory");
#pragma unroll
        for (int c = 0; c < 2; c++)
#pragma unroll
          for (int mt = 0; mt < 2; mt++)
#pragma unroll
            for (int kt = 0; kt < 2; kt++) {
              f32x4 acc = (f32x4){0.f, 0.f, 0.f, 0.f};
#pragma unroll
              for (int ks = 0; ks < 4; ks++) acc = mfma16(sf[c][kt][ks], qf[c][mt][ks], acc);
              float* d = SC + ((mt * 16 + l15) * 2 + c) * 33 + kt * 16 + quad * 4;
              d[0] = acc[0]; d[1] = acc[1]; d[2] = acc[2]; d[3] = acc[3];
            }
        if (qt < 3) {
#pragma unroll
          for (int c = 0; c < 2; c++)
#pragma unroll
            for (int kt = 0; kt < 2; kt++)
#pragma unroll
              for (int ks = 0; ks < 4; ks++)
                sf[c][kt][ks] = *(const u32x4*)(SK + ((size_t)(h * 2 + c) * 128 + (qt + 1) * 32 + kt * 16 + l15) * 128 + ks * 32 + quad * 8);
        }
        asm volatile("s_waitcnt lgkmcnt(0)" ::: "memory");
#pragma unroll 4
        for (int k = 0; k < 32; k++) {
          const float x = __uint_as_float((__float_as_uint(SC[lane * 33 + k]) & ~127u) | (unsigned)(qt * 32 + k));
          TOPK_INSERT(L, x)
        }
      }
      float* td = TOP + (((lane >> 1) * 8 + h) * 2 + (lane & 1)) * 16;
#pragma unroll
      for (int i = 0; i < 16; i++) td[i] = L[i];
    }
    __syncthreads();
    {
      const int tk = tid >> 3, h = tid & 7;
      const float* ta = TOP + ((tk * 8 + h) * 2) * 16;
      float va[16], vb[16];
#pragma unroll
      for (int i = 0; i < 16; i++) { va[i] = __uint_as_float(__float_as_uint(ta[i]) & ~127u); vb[i] = __uint_as_float(__float_as_uint(ta[16 + i]) & ~127u); }
      float W[16];
#pragma unroll
      for (int i = 0; i < 16; i++) W[i] = -3.0e38f;
#pragma unroll
      for (int i = 0; i < 16; i++)
#pragma unroll
        for (int j = 0; j < 16 / (i + 1); j++) {
          const float s = va[i] + vb[j];
          const float x = __uint_as_float((__float_as_uint(s) & ~255u) | (unsigned)(i * 16 + j));
          TOPK_INSERT(W, x)
        }
      const float m = __uint_as_float(__float_as_uint(W[0]) & ~255u);
      float ex[16]; float Z = 0;
#pragma unroll
      for (int k = 0; k < 16; k++) { ex[k] = __expf(__uint_as_float(__float_as_uint(W[k]) & ~255u) - m); Z += ex[k]; }
      const float iz = 1.f / Z;
      int* si = SELI + (size_t)(tok0 + tk) * 128 + h * 16; float* sg = SELG + (size_t)(tok0 + tk) * 128 + h * 16;
#pragma unroll
      for (int k = 0; k < 16; k++) {
        const unsigned ij = __float_as_uint(W[k]) & 255u;
        const unsigned i1 = __float_as_uint(ta[ij >> 4]) & 127u, i2 = __float_as_uint(ta[16 + (ij & 15)]) & 127u;
        si[k] = (int)(i1 * 128 + i2); sg[k] = ex[k] * iz;
      }
    }
    __syncthreads();
  }
}

#define UNPACK8(dst, o, u) { dst[o+0] = lo2f(u.x); dst[o+1] = hi2f(u.x); dst[o+2] = lo2f(u.y); dst[o+3] = hi2f(u.y); dst[o+4] = lo2f(u.z); dst[o+5] = hi2f(u.z); dst[o+6] = lo2f(u.w); dst[o+7] = hi2f(u.w); }

typedef __attribute__((ext_vector_type(2))) float f32x2;
DEV void fp8x16_to_f32x2(f32x2 (&f)[8], u32x4 u) {
  const unsigned w[4] = {u.x, u.y, u.z, u.w};
#pragma unroll
  for (int i = 0; i < 4; i++) {
    f[i * 2 + 0] = __builtin_amdgcn_cvt_pk_f32_fp8((int)w[i], false);
    f[i * 2 + 1] = __builtin_amdgcn_cvt_pk_f32_fp8((int)w[i], true);
  }
}

DEV void phase_peer_gather(const P& p, int l, unsigned char* smem) {
  const int lane = TID() & 63, wave = TID() >> 6;
  unsigned char* ws = WS(p);
  const unsigned char* U = ws + OFF_U + (size_t)l * 16384 * 1024 + lane * 16;
  const unsigned char* Vb = ws + OFF_V + (size_t)l * 16384 * 1024;
  const float* USC = (const float*)(ws + OFF_USC) + l * 16384;
  const float* VSC = (const float*)(ws + OFF_VSC) + l * 16384;
  const bf16_t* H = (const bf16_t*)(ws + OFF_H);
  const int* SELI = (const int*)(ws + OFF_SELI); const float* SELG = (const float*)(ws + OFF_SELG);
  const float* mod = (const float*)(ws + OFF_MOD);
  u32x2* TAB = (u32x2*)smem + wave * (12 * 128);
  const int nw = gridDim.x * 4, gw = blockIdx.x * 4 + wave;
  for (int tbase = gw; tbase < TT; tbase += nw * 12) {
    {
      int* IDS = (int*)TAB;
      float* DOT = (float*)TAB + 12 * 128;
      const int l15 = lane & 15, quad = lane >> 4;
#pragma unroll 1
      for (int ti = 0; ti < 12; ti++) {
        const int tok = tbase + nw * ti;
        int i0 = 0, i1 = 0;
        if (tok < TT) { i0 = SELI[(size_t)tok * 128 + lane]; i1 = SELI[(size_t)tok * 128 + 64 + lane]; }
        IDS[ti * 128 + lane] = i0; IDS[ti * 128 + 64 + lane] = i1;
        DOT[ti * 128 + lane] = 0.f; DOT[ti * 128 + 64 + lane] = 0.f;
      }
      asm volatile("s_waitcnt lgkmcnt(0)" ::: "memory");
      const unsigned char* Ub = ws + OFF_U + (size_t)l * 16384 * 1024 + quad * 32;
#pragma unroll 1
      for (int c = 0; c < 8; c++) {
#pragma unroll 2
        for (int ti = 0; ti < 12; ti++) {
          const int tok = tbase + nw * ti;
          if (tok >= TT) continue;
          const unsigned char* h8 = ws + OFF_H8 + (size_t)tok * 1024 + c * 128 + quad * 32;
          const u32x4 xb0 = *(const u32x4*)h8, xb1 = *(const u32x4*)(h8 + 16);
          u32x4 ua[8][2];
#pragma unroll
          for (int g = 0; g < 8; g++) {
            const int eid = IDS[ti * 128 + g * 16 + l15];
            const unsigned char* ur = Ub + (size_t)eid * 1024 + c * 128;
            ua[g][0] = *(const u32x4*)ur; ua[g][1] = *(const u32x4*)(ur + 16);
          }
#pragma unroll
          for (int g = 0; g < 8; g++) {
            f32x4 acc = (f32x4){0.f, 0.f, 0.f, 0.f};
            acc = __builtin_amdgcn_mfma_f32_16x16x32_fp8_fp8((long)(((unsigned long long)ua[g][0].y << 32) | ua[g][0].x), (long)(((unsigned long long)xb0.y << 32) | xb0.x), acc, 0, 0, 0);
            acc = __builtin_amdgcn_mfma_f32_16x16x32_fp8_fp8((long)(((unsigned long long)ua[g][0].w << 32) | ua[g][0].z), (long)(((unsigned long long)xb0.w << 32) | xb0.z), acc, 0, 0, 0);
            acc = __builtin_amdgcn_mfma_f32_16x16x32_fp8_fp8((long)(((unsigned long long)ua[g][1].y << 32) | ua[g][1].x), (long)(((unsigned long long)xb1.y << 32) | xb1.x), acc, 0, 0, 0);
            acc = __builtin_amdgcn_mfma_f32_16x16x32_fp8_fp8((long)(((unsigned long long)ua[g][1].w << 32) | ua[g][1].z), (long)(((unsigned long long)xb1.w << 32) | xb1.z), acc, 0, 0, 0);
            if (l15 == 0) {
              float* d = DOT + ti * 128 + g * 16 + quad * 4;
              f32x4 cur = *(f32x4*)d;
              cur[0] += acc[0]; cur[1] += acc[1]; cur[2] += acc[2]; cur[3] += acc[3];
              *(f32x4*)d = cur;
            }
          }
        }
      }
      asm volatile("s_waitcnt lgkmcnt(0)" ::: "memory");
      int idl[12], idh[12]; float dl[12], dh[12];
#pragma unroll
      for (int ti = 0; ti < 12; ti++) { idl[ti] = IDS[ti * 128 + lane]; idh[ti] = IDS[ti * 128 + 64 + lane]; dl[ti] = DOT[ti * 128 + lane]; dh[ti] = DOT[ti * 128 + 64 + lane]; }
      asm volatile("s_waitcnt lgkmcnt(0)" ::: "memory");
#pragma unroll
      for (int ti = 0; ti < 12; ti++) {
        const int tok = tbase + nw * ti;
        u32x2 e0 = (u32x2){0u, 0u}, e1 = (u32x2){0u, 0u};
        if (tok < TT) {
          const float hs = ((const float*)(ws + OFF_HSC))[tok];
          const float g0 = SELG[(size_t)tok * 128 + lane], g1 = SELG[(size_t)tok * 128 + 64 + lane];
          const float d0 = dl[ti] * hs * USC[idl[ti]], d1 = dh[ti] * hs * USC[idh[ti]];
          const float a0 = 0.5f * d0 * (1.f + erff(d0 * 0.7071067811865475f)) * g0 * VSC[idl[ti]];
          const float a1 = 0.5f * d1 * (1.f + erff(d1 * 0.7071067811865475f)) * g1 * VSC[idh[ti]];
          e0 = (u32x2){(unsigned)idl[ti], __float_as_uint(a0)}; e1 = (u32x2){(unsigned)idh[ti], __float_as_uint(a1)};
        }
        TAB[ti * 128 + lane] = e0; TAB[ti * 128 + 64 + lane] = e1;
      }
    }
    asm volatile("s_waitcnt lgkmcnt(0)" ::: "memory");
    const int tq = lane >> 4, li = lane & 15;
#pragma unroll 1
    for (int c = 0; c < 8; c++) {
      const unsigned char* Vc = Vb + c * 128 + li * 8;
#pragma unroll 1
      for (int step = 0; step < 3; step++) {
        const int ti = step * 4 + tq;
        const int tok = tbase + nw * ti;
        const u32x2* tab = TAB + ti * 128;
        float acc[8];
#pragma unroll
        for (int i = 0; i < 8; i++) acc[i] = 0.f;
#pragma unroll 1
        for (int k = 0; k < 128; k += 32) {
          u32x2 rows[32]; float aw[32];
#pragma unroll
          for (int g = 0; g < 32; g++) { const u32x2 e = tab[k + g]; aw[g] = __uint_as_float(e.y); rows[g] = *(const u32x2*)(Vc + (size_t)e.x * 1024); }
#pragma unroll
          for (int g = 0; g < 32; g++) {
            const f32x2 f0 = __builtin_amdgcn_cvt_pk_f32_fp8((int)rows[g].x, false), f1 = __builtin_amdgcn_cvt_pk_f32_fp8((int)rows[g].x, true);
            const f32x2 f2 = __builtin_amdgcn_cvt_pk_f32_fp8((int)rows[g].y, false), f3 = __builtin_amdgcn_cvt_pk_f32_fp8((int)rows[g].y, true);
            acc[0] += aw[g] * f0[0]; acc[1] += aw[g] * f0[1]; acc[2] += aw[g] * f1[0]; acc[3] += aw[g] * f1[1];
            acc[4] += aw[g] * f2[0]; acc[5] += aw[g] * f2[1]; acc[6] += aw[g] * f3[0]; acc[7] += aw[g] * f3[1];
          }
        }
        if (tok < TT) {
          const float* gt = mod + (size_t)(l * 5 + cond_of(tok)) * 6144 + 5 * 1024 + c * 128 + li * 8;
          float* xo = OUT(p) + (size_t)tok * 1024 + c * 128 + li * 8;
#pragma unroll
          for (int q = 0; q < 2; q++) {
            f32x4 xv = *(f32x4*)(xo + q * 4); const f32x4 gg = *(const f32x4*)(gt + q * 4);
#pragma unroll
            for (int j = 0; j < 4; j++) xv[j] += gg[j] * acc[q * 4 + j];
            *(f32x4*)(xo + q * 4) = xv;
          }
        }
      }
    }
    if (l < 3) {
      asm volatile("s_waitcnt vmcnt(0)" ::: "memory");
#pragma unroll 1
      for (int ti = 0; ti < 12; ti++) {
        const int tok = tbase + nw * ti;
        if (tok >= TT) continue;
        const float* xo = OUT(p) + (size_t)tok * 1024 + lane * 16;
        f32x4 xn[4]; float ss = 0.f;
#pragma unroll
        for (int q = 0; q < 4; q++) { xn[q] = *(const f32x4*)(xo + q * 4); ss += xn[q][0] * xn[q][0] + xn[q][1] * xn[q][1] + xn[q][2] * xn[q][2] + xn[q][3] * xn[q][3]; }
#pragma unroll
        for (int o = 32; o >= 1; o >>= 1) ss += __shfl_xor(ss, o);
        const float rstd = rsqrtf(ss * (1.f / 1024.f) + EPS);
        const float* g1 = IN(p, I_GNORM) + (size_t)((l + 1) * 2) * 1024 + lane * 16;
        const float* mb = mod + (size_t)((l + 1) * 5 + cond_of(tok)) * 6144 + lane * 16;
        unsigned hw[8];
#pragma unroll
        for (int q = 0; q < 4; q++) {
          const f32x4 gg = *(const f32x4*)(g1 + q * 4), sh = *(const f32x4*)(mb + q * 4), sc = *(const f32x4*)(mb + 1024 + q * 4);
          f32x4 o;
#pragma unroll
          for (int j = 0; j < 4; j++) o[j] = xn[q][j] * rstd * gg[j] * (1.f + sc[j]) + sh[j];
          const u32x2 pk = pack4(o); hw[q * 2] = pk.x; hw[q * 2 + 1] = pk.y;
        }
        bf16_t* hd = (bf16_t*)(ws + OFF_H) + (size_t)tok * 1024 + lane * 16;
        *(u32x4*)hd = mk4(hw[0], hw[1], hw[2], hw[3]); *(u32x4*)(hd + 8) = mk4(hw[4], hw[5], hw[6], hw[7]);
      }
    }
    asm volatile("s_waitcnt lgkmcnt(0)" ::: "memory");
  }
}

DEV int next_item(unsigned* ctr, int* slot) {
  __syncthreads();
  if (TID() == 0) *slot = (int)atomicAdd(ctr, 1u);
  __syncthreads();
  return *slot;
}


#define XB_TMO      128
#define XB_XCNT(j)  (256  + 64 * (j))
#define XB_XSUB(j)  (1280 + 64 * (j))
#define XB_XGEN(j)  (2304 + 64 * (j))
#define XB_TOP      3328
#define XB_TOPGEN   3392
#define XCD_BAR_WORDS 3456
#define XB_SPIN_CAP (1u << 22)
#define LAS __attribute__((address_space(3)))
DEV unsigned xb_ld(unsigned* p)              { return __hip_atomic_load(p, __ATOMIC_RELAXED, __HIP_MEMORY_SCOPE_AGENT); }
DEV unsigned xb_add(unsigned* p, unsigned v) { return __hip_atomic_fetch_add(p, v, __ATOMIC_RELAXED, __HIP_MEMORY_SCOPE_AGENT); }
DEV unsigned xb_xcc_id() { return (unsigned)__builtin_amdgcn_s_getreg((3 << 11) | 20) & 0xFu; }
#define XB_SPIN(cond, bar) do { unsigned _sp = 0; while (cond) { __builtin_amdgcn_s_sleep(1); \
    if ((++_sp & 255u) == 0u) { if (xb_ld(&(bar)[XB_TMO])) break; if (_sp > XB_SPIN_CAP) { atomicAdd(&(bar)[XB_TMO], 1u); break; } } } } while (0)
struct XcdBarrier { unsigned* bar; unsigned x; volatile LAS unsigned* st; };
DEV XcdBarrier xcd_barrier_post(unsigned* bar, volatile LAS unsigned* st) {
  XcdBarrier b; b.bar = bar; b.x = xb_xcc_id(); b.st = st;
  if (threadIdx.x == 0) (void)xb_add(&bar[XB_XCNT(b.x)], 1u);
  return b;
}
DEV void xcd_barrier_complete(unsigned* bar, unsigned x, unsigned& nloc, unsigned& nx) {
  const unsigned G = gridDim.x * gridDim.y * gridDim.z;
  unsigned sum, cnt, mine, sp = 0u;
  for (;;) {
    sum = 0u; cnt = 0u; mine = 0u;
#pragma unroll
    for (unsigned j = 0; j < 16; ++j) { const unsigned c = xb_ld(&bar[XB_XCNT(j)]); sum += c; cnt += (c > 0u) ? 1u : 0u; mine = (j == x) ? c : mine; }
    if (sum == G) break;
    __builtin_amdgcn_s_sleep(1);
    if ((++sp & 255u) == 0u) { if (xb_ld(&bar[XB_TMO])) break; if (sp > XB_SPIN_CAP) { atomicAdd(&bar[XB_TMO], 1u); break; } }
  }
  nloc = mine > 0u ? mine : 1u; nx = cnt > 0u ? cnt : 1u;
}
DEV void xcd_barrier(const XcdBarrier& b) {
  asm volatile("s_waitcnt vmcnt(0)" ::: "memory");
  __syncthreads();
  if (threadIdx.x == 0) {
    unsigned* bar = b.bar;
    __builtin_amdgcn_s_waitcnt(0);
    unsigned nloc = b.st[0], nx = b.st[1];
    if (nloc == 0u) { xcd_barrier_complete(bar, b.x, nloc, nx); b.st[0] = nloc; b.st[1] = nx; }
    const unsigned old = xb_add(&bar[XB_XSUB(b.x)], 1u);
    const unsigned gen = old / nloc;
    if (old + 1u == (gen + 1u) * nloc) {
      __builtin_amdgcn_fence(__ATOMIC_RELEASE, "agent");
      asm volatile("s_waitcnt vmcnt(0)" ::: "memory");
      const unsigned og = xb_add(&bar[XB_TOP], 1u);
      const unsigned tg = og / nx;
      if (og + 1u == (tg + 1u) * nx) xb_add(&bar[XB_TOPGEN], 1u);
      else XB_SPIN(xb_ld(&bar[XB_TOPGEN]) == tg, bar);
      __builtin_amdgcn_fence(__ATOMIC_ACQUIRE, "agent");
      xb_add(&bar[XB_XGEN(b.x)], 1u);
      asm volatile("s_waitcnt vmcnt(0)" ::: "memory");
    } else {
      XB_SPIN(xb_ld(&bar[XB_XGEN(b.x)]) == gen, bar);
      __builtin_amdgcn_fence(__ATOMIC_ACQUIRE, "agent");
      asm volatile("s_waitcnt vmcnt(0)" ::: "memory");
    }
  }
  __syncthreads();
}

__global__ void __launch_bounds__(256, 2) mega(P p) {
  extern __shared__ __attribute__((aligned(16))) unsigned char smem[];
  cg::grid_group grid = cg::this_grid();
  unsigned char* ws = WS(p);
  unsigned* ctr = (unsigned*)(ws + OFF_CTR);
  int* slot = (int*)(smem + LDS_BYTES - 16);
  int ph = 0;
  volatile LAS unsigned* xst = (volatile LAS unsigned*)(smem + LDS_BYTES - 32);
  if (threadIdx.x == 0) { xst[0] = 0u; xst[1] = 0u; }
  __syncthreads();
  XcdBarrier xbar = xcd_barrier_post((unsigned*)(ws + OFF_BAR), xst);
#define RUN(...) do { if (ph >= p.ph_lo && ph < p.ph_hi) { __VA_ARGS__; if (ph + 1 < p.ph_hi) { if (ph == p.ph_lo) grid.sync(); else xcd_barrier(xbar); } } ++ph; } while (0)
#define RUNK(kind, ...) do { RUN(__VA_ARGS__); if (DUP_KIND == (kind)) RUN(__VA_ARGS__); } while (0)

  RUN({ phase_prologue(p, smem); });
#if DUP_KIND == 6
  RUN({ phase_prologue(p, smem); });
#endif

  for (int l = 0; l < 4; l++) {
    const int e = l >> 1;
    if ((l & 1) == 0) {
      if (l == 0) RUNK(7, { phase_norm(p, l, 0); });
      RUNK(2, { const int nbx = gridDim.x >> 3, nfull = (12 * 17 / nbx) * nbx;
            for (int t = blockIdx.x >> 3; t < nfull; t += nbx)
              gemm_tile<EPI_EVEN_IN, 0, 4>(p, l, (const bf16_t*)(ws + OFF_H), 1024, (const bf16_t*)(ws + OFF_WINE) + (size_t)e * 2176 * 1024, 1024, 1024, ((t / 17) * 8 + (blockIdx.x & 7)) * 256, (t % 17) * 128, smem, 0);
            for (int u = blockIdx.x >> 3; u < (12 * 17 - nfull) * 2; u += nbx) { const int t = nfull + (u >> 1);
              gemm_tile<EPI_EVEN_IN, 0, 2>(p, l, (const bf16_t*)(ws + OFF_H), 1024, (const bf16_t*)(ws + OFF_WINE) + (size_t)e * 2176 * 1024, 1024, 1024, ((t / 17) * 8 + (blockIdx.x & 7)) * 256 + (u & 1) * 128, (t % 17) * 128, smem, 0); } });
      RUNK(7, { phase_mla_prep(p, e); for (int u = blockIdx.x; u < 3072; u += gridDim.x) gla_local(p, e, u, smem); });
      RUNK(2, { const int xv = blockIdx.x & 7;
            for (int t = blockIdx.x >> 3; t < 96 + 52 + 52; t += gridDim.x >> 3) {
              if (t < 96) gemm_tile<EPI_UQ, 0, 4>(p, l, (const bf16_t*)(ws + OFF_CQN), 256, (const bf16_t*)(ws + OFF_WUQ) + (size_t)e * 1024 * 256, 256, 256, ((t >> 3) * 8 + xv) * 256, (t & 7) * 128, smem, 0);
              else if (t < 96 + 52) { int u = t - 96; gemm_tile<EPI_UK, 0, 4>(p, l, (const bf16_t*)(ws + OFF_CKVN), 256, (const bf16_t*)(ws + OFF_WUK) + (size_t)e * 512 * 256, 256, 256, ((u >> 2) * 8 + xv) * 256, (u & 3) * 128, smem, 0); }
              else { int u = t - 96 - 52; gemm_tile<EPI_UV, 0, 4>(p, l, (const bf16_t*)(ws + OFF_CKVN), 256, (const bf16_t*)(ws + OFF_WUV) + (size_t)e * 512 * 256, 256, 256, ((u >> 2) * 8 + xv) * 256, (u & 3) * 128, smem, 0); }
            } });
      RUNK(3, {
            for (int it = next_item(ctr + ph, slot); it < 1824; it = next_item(ctr + ph, slot)) {
              if (it < 32) { __builtin_amdgcn_s_setprio(3); gla_seq(p, e, it); __builtin_amdgcn_s_setprio(0); }
              else if (it < 1056) mla_attn_item(p, it - 32, smem);
              else if (it < 1312) gla_seq(p, e, it - 1056 + 32);
              else mla_attn_item(p, it - 1312 + 1024, smem);
            } });
      RUNK(7, { phase_gla_out(p, e); });
      RUN({ const int nbx = gridDim.x >> 3, nfull = (12 * 8 / nbx) * nbx;
            for (int t = blockIdx.x >> 3; t < nfull; t += nbx)
              gemm_tile<EPI_OUT, 0, 4>(p, l, (const bf16_t*)(ws + OFF_MIX), 1024, (const bf16_t*)(ws + OFF_WOE) + (size_t)e * 1024 * 1024, 1024, 1024, ((t >> 3) * 8 + (blockIdx.x & 7)) * 256, (t & 7) * 128, smem, 0);
            for (int u = blockIdx.x >> 3; u < (12 * 8 - nfull) * 2; u += nbx) { const int t = nfull + (u >> 1);
              gemm_tile<EPI_OUT, 0, 2>(p, l, (const bf16_t*)(ws + OFF_MIX), 1024, (const bf16_t*)(ws + OFF_WOE) + (size_t)e * 1024 * 1024, 1024, 1024, ((t >> 3) * 8 + (blockIdx.x & 7)) * 256 + (u & 1) * 128, (t & 7) * 128, smem, 0); } });
    } else {
      RUNK(2, { phase_winctx(p, e); for (int t = blockIdx.x >> 3; t < 12 * 10; t += gridDim.x >> 3)
              gemm_tile<EPI_ODD_IN, 0, 4>(p, l, (const bf16_t*)(ws + OFF_H), 1024, (const bf16_t*)(ws + OFF_WINO) + (size_t)e * 1280 * 1024, 1024, 1024, ((t / 10) * 8 + (blockIdx.x & 7)) * 256, (t % 10) * 128, smem, 0); });
      RUNK(4, {
            for (int it = next_item(ctr + ph, slot); it < 2304; it = next_item(ctr + ph, slot)) {
              if (it < 1024) win_attn_item(p, e, it, smem);
              else if (it < 1792) { int u = it - 1024; int g = u & 3;
                gemm_tile<EPI_POOL, 1, 2>(p, l, (const bf16_t*)(ws + OFF_PROJ), 512, (const bf16_t*)(ws + OFF_WPOOL) + (size_t)(e * 4 + g) * 16384, 128, 128, (u >> 2) * 128, 0, smem, g); }
              else win_attn_item(p, e, it - 1792 + 1024, smem);
            } });
      RUN({ const int nbx = gridDim.x >> 3, nfull = (12 * 8 / nbx) * nbx;
            for (int t = blockIdx.x >> 3; t < nfull; t += nbx)
              gemm_tile<EPI_OUT, 0, 4>(p, l, (const bf16_t*)(ws + OFF_MIX), 1024, (const bf16_t*)(ws + OFF_WOO) + (size_t)e * 1024 * 1024, 1024, 1024, ((t >> 3) * 8 + (blockIdx.x & 7)) * 256, (t & 7) * 128, smem, 0);
            for (int u = blockIdx.x >> 3; u < (12 * 8 - nfull) * 2; u += nbx) { const int t = nfull + (u >> 1);
              gemm_tile<EPI_OUT, 0, 2>(p, l, (const bf16_t*)(ws + OFF_MIX), 1024, (const bf16_t*)(ws + OFF_WOO) + (size_t)e * 1024 * 1024, 1024, 1024, ((t >> 3) * 8 + (blockIdx.x & 7)) * 256 + (u & 1) * 128, (t & 7) * 128, smem, 0); } });
    }
    RUNK(7, { phase_norm(p, l, 1); });
    RUNK(2, { for (int t = blockIdx.x >> 3; t < 12 * 16; t += gridDim.x >> 3)
            gemm_tile<EPI_PQ, 0, 4>(p, l, (const bf16_t*)(ws + OFF_H), 1024, (const bf16_t*)(ws + OFF_WQ) + (size_t)l * 2048 * 1024, 1024, 1024, ((t >> 4) * 8 + (blockIdx.x & 7)) * 256, (t & 15) * 128, smem, 0); });
    RUNK(5, { phase_peer_select(p, l, smem); });
    RUN({ phase_peer_gather(p, l, smem); });
  }
#undef RUN
#undef RUNK
}

extern "C" void kernel_launch(void* const* d_in, const int* in_sizes, int n_in, void* d_out, int out_size, void* d_ws, size_t ws_size, hipStream_t stream) {
  static int grid_blocks = 0;
  if (grid_blocks == 0) {
    if (ws_size < WS_END) { fprintf(stderr, "kernel_launch: workspace too small: %zu < %zu\n", ws_size, (size_t)WS_END); grid_blocks = -1; return; }
    int dev = 0, cus = 0, per_cu = 0;
    hipGetDevice(&dev);
    hipDeviceGetAttribute(&cus, hipDeviceAttributeMultiprocessorCount, dev);
    hipFuncSetAttribute((const void*)mega, hipFuncAttributeMaxDynamicSharedMemorySize, LDS_BYTES);
    hipOccupancyMaxActiveBlocksPerMultiprocessor(&per_cu, (const void*)mega, 256, LDS_BYTES);
    if (per_cu < 1) per_cu = 1;
    if (per_cu > 2) per_cu = 2;
    grid_blocks = cus * per_cu;
    grid_blocks -= grid_blocks % 8;
  }
  if (grid_blocks < 0) return;
  (void)hipMemsetAsync((char*)d_ws + OFF_CTR, 0, 256 + XCD_BAR_WORDS * 4, stream);
  P p{};
  for (int i = 0; i < 34; i++) p.in[i] = (const float*)d_in[i];
  p.out = (float*)d_out; p.ws = (unsigned char*)d_ws;
#if N_LAUNCH_PER_PHASE
  for (int ph = 0; ph < NPHASES; ph++) {
    p.ph_lo = ph; p.ph_hi = ph + 1;
    hipLaunchKernelGGL(mega, dim3(grid_blocks), dim3(256), LDS_BYTES, stream, p);
  }
#else
  p.ph_lo = 0; p.ph_hi = NPHASES + (DUP_KIND ? 64 : 0);
  void* args[] = {&p};
  hipError_t e = hipLaunchCooperativeKernel((const void*)mega, dim3(grid_blocks), dim3(256), args, LDS_BYTES, stream);
  if (e != hipSuccess) fprintf(stderr, "cooperative launch failed: %s (grid %d)\n", hipGetErrorString(e), grid_blocks);
#endif
}
```
